# Optimizing an MI355X kernel written in HIP

```python
import math
import jax, jax.numpy as jnp
from jax import lax
import numpy as np

D_MODEL = 1024
BATCH = 32
SEQ = 2048
DEPTH = 2

H_A = 4
DH_A = 64
W_A = H_A * 2 * DH_A
Q_BLOCK = 128
ROPE_THETA = 10000.0
H_B = 8
N_B = 64
W_B = H_B * N_B
R_W = 64
R_A = 64
R_G = 160
RWKV_LN_EPS = 64e-5
H_C = 4
DK_C = 128
DV_C = 128
W_C = H_C * DK_C
HGRN_CHUNK = 32
D_FF = 2816
N_MOD = 9
EPS = 1e-6

P_A = 3 * W_A
P_B = 3 * W_B + R_W + R_A + R_G
P_C = 4 * W_C
P_G = 3 * D_MODEL
P_TOTAL = P_A + P_B + P_C + P_G

kernel_name = 'hybrid_diffattn_rwkv7_hgrn2_block'


def rms_norm(x, w, eps=EPS):
    xf = x.astype(jnp.float32)
    y = xf * lax.rsqrt(jnp.mean(xf * xf, axis=-1, keepdims=True) + eps)
    return (y * w.astype(jnp.float32)).astype(x.dtype)


def modulate(n, shift, scale):
    return n * (1.0 + scale) + shift


def swiglu(u, w_gate, w_up, w_down):
    return (jax.nn.silu(u @ w_gate) * (u @ w_up)) @ w_down


def rope(t, positions):
    dh = t.shape[-1]
    inv = ROPE_THETA ** (-jnp.arange(0, dh, 2, dtype=jnp.float32) / dh)
    ang = positions.astype(jnp.float32)[..., None] * inv
    cos = jnp.cos(ang)[:, :, None, None, :]
    sin = jnp.sin(ang)[:, :, None, None, :]
    tf = t.astype(jnp.float32)
    t1, t2 = tf[..., : dh // 2], tf[..., dh // 2:]
    return jnp.concatenate([t1 * cos - t2 * sin, t2 * cos + t1 * sin], axis=-1).astype(t.dtype)


def diff_attention(q, k, v, positions, qk_norm_w, lambda_qk, subln_w, layer_idx):
    B, S = q.shape[0], q.shape[1]
    q = rope(rms_norm(q, qk_norm_w[0]), positions)
    k = rope(rms_norm(k, qk_norm_w[1]), positions)
    lam_init = 0.8 - 0.6 * math.exp(-0.3 * layer_idx)
    lq = lambda_qk.astype(jnp.float32)
    lam = jnp.exp(jnp.sum(lq[0] * lq[1])) - jnp.exp(jnp.sum(lq[2] * lq[3])) + lam_init
    scale = DH_A ** -0.5
    outs = []
    for blk in range(S // Q_BLOCK):
        q0 = blk * Q_BLOCK
        kv_len = q0 + Q_BLOCK
        qb = q[:, q0:kv_len]
        kb = k[:, :kv_len]
        vb = v[:, :kv_len]
        s = jnp.einsum('bqhmd,bkhmd->bhmqk', qb, kb, preferred_element_type=jnp.float32) * scale
        causal = jnp.arange(kv_len)[None, :] <= (q0 + jnp.arange(Q_BLOCK))[:, None]
        p = jax.nn.softmax(jnp.where(causal, s, -jnp.inf), axis=-1)
        p = p[:, :, 0] - lam * p[:, :, 1]
        outs.append(jnp.einsum('bhqk,bkhe->bqhe', p.astype(v.dtype), vb))
    o = jnp.concatenate(outs, axis=1)
    o = rms_norm(o, subln_w) * (1.0 - lam_init)
    return o.reshape(B, S, W_A)


def token_shift(p):
    return jnp.pad(p, ((0, 0), (1, 0), (0, 0)))[:, :-1]


def rwkv7_scan(r, decay, k, v, kk, a):
    B, _, H, N = r.shape

    def step(state, inp):
        r_t, w_t, k_t, v_t, kk_t, a_t = inp
        s_kk = jnp.einsum('bhvk,bhk->bhv', state, kk_t)
        state = (state * w_t[:, :, None, :]
                 - s_kk[..., None] * (kk_t * a_t)[:, :, None, :]
                 + v_t[..., None] * k_t[:, :, None, :])
        return state, jnp.einsum('bhvk,bhk->bhv', state, r_t)

    xs = (jnp.moveaxis(t, 1, 0) for t in (r, decay, k, v, kk, a))
    _, out = lax.scan(step, jnp.zeros((B, H, N, N), jnp.float32), tuple(xs))
    return jnp.moveaxis(out, 0, 1)


def rwkv7_time_mix(p, mu, w0, w2, a0, a2, g2, k_k, k_a, r_k, ln_w, ln_b):
    B, S, _ = p.shape
    f32 = jnp.float32
    p = p + (token_shift(p) - p) * mu
    o1, o2, o3 = W_B, 2 * W_B, 3 * W_B
    r, k, v = p[..., :o1], p[..., o1:o2], p[..., o2:o3]
    xw = p[..., o3:o3 + R_W]
    xa = p[..., o3 + R_W:o3 + R_W + R_A]
    xg = p[..., o3 + R_W + R_A:]
    w = -jax.nn.softplus(-(w0 + jnp.tanh(xw) @ w2)) - 0.5
    decay = jnp.exp(-jnp.exp(w.astype(f32)))
    a = jax.nn.sigmoid(a0 + xa @ a2)
    g = jax.nn.sigmoid(xg) @ g2
    heads = lambda t: t.astype(f32).reshape(B, S, H_B, N_B)
    kk = heads(k * k_k)
    kk = kk / jnp.maximum(jnp.sqrt(jnp.sum(kk * kk, axis=-1, keepdims=True)), 1e-12)
    k = k * (1.0 + (a - 1.0) * k_a)
    rh, kh, vh, ah = heads(r), heads(k), heads(v), heads(a)
    o = rwkv7_scan(rh, heads(decay), kh, vh, kk, ah)
    mean = jnp.mean(o, axis=-1, keepdims=True)
    var = jnp.mean(jnp.square(o - mean), axis=-1, keepdims=True)
    o = ((o - mean) * lax.rsqrt(var + RWKV_LN_EPS)).reshape(B, S, W_B)
    o = o * ln_w.astype(f32) + ln_b.astype(f32)
    bonus = jnp.sum(rh * kh * r_k.astype(f32), axis=-1, keepdims=True) * vh
    o = o + bonus.reshape(B, S, W_B)
    return (o * g.astype(f32)).astype(p.dtype)


def hgrn2_chunked(q, k, v, log_f):
    B, S, H, dk = q.shape
    dv = v.shape[-1]
    C = HGRN_CHUNK
    n = S // C
    to_chunks = lambda t: t.reshape(B, n, C, H, t.shape[-1]).transpose(1, 0, 3, 2, 4)
    causal = jnp.tril(jnp.ones((C, C), dtype=bool))

    def step(state, inp):
        qc, kc, vc, lfc = inp
        b = jnp.cumsum(lfc, axis=2)
        o_inter = jnp.einsum('bhtk,bhkv->bhtv', qc * jnp.exp(b), state)
        diff = jnp.where(causal[:, :, None], b[:, :, :, None, :] - b[:, :, None, :, :], -jnp.inf)
        scores = jnp.einsum('bhtk,bhsk,bhtsk->bhts', qc, kc, jnp.exp(diff))
        o_intra = jnp.einsum('bhts,bhsv->bhtv', scores, vc)
        b_end = b[:, :, -1:, :]
        state = (jnp.exp(b_end[:, :, 0, :])[..., None] * state
                 + jnp.einsum('bhsk,bhsv->bhkv', kc * jnp.exp(b_end - b), vc))
        return state, o_inter + o_intra

    xs = tuple(to_chunks(t) for t in (q, k, v, log_f))
    _, o = lax.scan(step, jnp.zeros((B, H, dk, dv), jnp.float32), xs)
    return o.transpose(1, 0, 3, 2, 4).reshape(B, S, H, dv)


def hgrn2_mix(p, lower_bound, norm_w):
    B, S, _ = p.shape
    f32 = jnp.float32
    q, fz, i, g = jnp.split(p, 4, axis=-1)
    q = jax.nn.silu(q.astype(f32)).reshape(B, S, H_C, DK_C)
    lb = lower_bound.astype(f32)
    log_f = jnp.logaddexp(jnp.log(lb), jnp.log1p(-lb) + jax.nn.log_sigmoid(fz.astype(f32)))
    log_f = log_f.reshape(B, S, H_C, DK_C)
    k = -jnp.expm1(log_f)
    o = hgrn2_chunked(q, k, i.astype(f32).reshape(B, S, H_C, DV_C), log_f)
    o = rms_norm(o, norm_w) * jax.nn.silu(g.astype(f32).reshape(B, S, H_C, DV_C))
    return o.reshape(B, S, W_C).astype(p.dtype)


def hybrid_mixer(u, positions, layer_idx, w_in, qk_norm_w, lambda_qk, subln_w, w_out_a,
                 rwkv_mu, rwkv_w0, rwkv_w2, rwkv_a0, rwkv_a2, rwkv_g2, rwkv_k_k, rwkv_k_a,
                 rwkv_r_k, rwkv_ln_w, rwkv_ln_b, w_out_b, lower_bound, hgrn_norm_w, w_out_c, w_out):
    B, S, _ = u.shape
    p = u @ w_in
    pa = p[..., :P_A]
    pb = p[..., P_A:P_A + P_B]
    pc = p[..., P_A + P_B:P_A + P_B + P_C]
    pg = p[..., P_A + P_B + P_C:]
    qa = pa[..., :W_A].reshape(B, S, H_A, 2, DH_A)
    ka = pa[..., W_A:2 * W_A].reshape(B, S, H_A, 2, DH_A)
    va = pa[..., 2 * W_A:].reshape(B, S, H_A, 2 * DH_A)
    y_a = diff_attention(qa, ka, va, positions, qk_norm_w, lambda_qk, subln_w, layer_idx) @ w_out_a
    y_b = rwkv7_time_mix(pb, rwkv_mu, rwkv_w0, rwkv_w2, rwkv_a0, rwkv_a2, rwkv_g2,
                         rwkv_k_k, rwkv_k_a, rwkv_r_k, rwkv_ln_w, rwkv_ln_b) @ w_out_b
    y_c = hgrn2_mix(pc, lower_bound, hgrn_norm_w) @ w_out_c
    g_a, g_b, g_c = jnp.split(jax.nn.sigmoid(pg), 3, axis=-1)
    return (g_a * y_a + g_b * y_b + g_c * y_c) @ w_out


def setup_inputs(seed: int = 0) -> dict:
    key = jax.random.key(seed)
    ks = iter(jax.random.split(key, 40))
    f32 = jnp.float32
    L, D = DEPTH, D_MODEL

    def nrm(shape, scale):
        return jax.random.normal(next(ks), shape, f32) * scale

    def gain(shape):
        return 1.0 + nrm(shape, 0.02)

    x = nrm((BATCH, SEQ, D), 1.0)
    c = nrm((BATCH, D), 1.0)
    offsets = jax.random.randint(next(ks), (BATCH, 1), 0, 4096, dtype=jnp.int32)
    positions = (offsets + jnp.arange(SEQ, dtype=jnp.int32)[None, :]).astype(jnp.int32)
    return {
        'x': x,
        'c': c,
        'positions': positions,
        'mod_w': nrm((L, D, N_MOD * D), 0.5 * D ** -0.5),
        'mod_b': nrm((L, N_MOD * D), 0.02),
        'norm_w': gain((L, 3, D)),
        'ffn_w_gate': nrm((L, 2, D, D_FF), D ** -0.5),
        'ffn_w_up': nrm((L, 2, D, D_FF), D ** -0.5),
        'ffn_w_down': nrm((L, 2, D_FF, D), D_FF ** -0.5),
        'w_in': nrm((L, D, P_TOTAL), D ** -0.5),
        'qk_norm_w': gain((L, 2, DH_A)),
        'lambda_qk': nrm((L, 4, DH_A), 0.1),
        'subln_w': gain((L, 2 * DH_A)),
        'w_out_a': nrm((L, W_A, D), W_A ** -0.5),
        'rwkv_mu': jax.random.uniform(next(ks), (L, P_B), f32, 0.0, 1.0),
        'rwkv_w0': jax.random.uniform(next(ks), (L, W_B), f32, -6.0, 0.0),
        'rwkv_w2': nrm((L, R_W, W_B), R_W ** -0.5),
        'rwkv_a0': nrm((L, W_B), 0.1),
        'rwkv_a2': nrm((L, R_A, W_B), R_A ** -0.5),
        'rwkv_g2': nrm((L, R_G, W_B), R_G ** -0.5),
        'rwkv_k_k': 0.85 + nrm((L, W_B), 0.05),
        'rwkv_k_a': 1.0 + nrm((L, W_B), 0.05),
        'rwkv_r_k': nrm((L, H_B, N_B), 0.1),
        'rwkv_ln_w': gain((L, W_B)),
        'rwkv_ln_b': nrm((L, W_B), 0.02),
        'w_out_b': nrm((L, W_B, D), W_B ** -0.5),
        'hgrn_lower_bounds': nrm((L, W_C), 0.5),
        'hgrn_norm_w': gain((L, DV_C)),
        'w_out_c': nrm((L, W_C, D), W_C ** -0.5),
        'w_out': nrm((L, D, D), D ** -0.5),
    }


def reference(x, c, positions, mod_w, mod_b, norm_w, ffn_w_gate, ffn_w_up, ffn_w_down,
              w_in, qk_norm_w, lambda_qk, subln_w, w_out_a,
              rwkv_mu, rwkv_w0, rwkv_w2, rwkv_a0, rwkv_a2, rwkv_g2, rwkv_k_k, rwkv_k_a,
              rwkv_r_k, rwkv_ln_w, rwkv_ln_b, w_out_b,
              hgrn_lower_bounds, hgrn_norm_w, w_out_c, w_out):
    B, S, D = x.shape
    lb = jnp.cumsum(jax.nn.softmax(hgrn_lower_bounds.astype(jnp.float32), axis=0), axis=0)
    lb = lb - lb[0]
    cond = jax.nn.silu(c)
    h = x
    for l in range(DEPTH):
        mod = (cond @ mod_w[l] + mod_b[l]).reshape(B, N_MOD, D)
        m = [mod[:, j, None, :] for j in range(N_MOD)]
        u = modulate(rms_norm(h, norm_w[l, 0]), m[0], m[1])
        h = h + 0.5 * m[2] * swiglu(u, ffn_w_gate[l, 0], ffn_w_up[l, 0], ffn_w_down[l, 0])
        u = modulate(rms_norm(h, norm_w[l, 1]), m[3], m[4])
        y = hybrid_mixer(u, positions, l, w_in[l], qk_norm_w[l], lambda_qk[l], subln_w[l], w_out_a[l],
                         rwkv_mu[l], rwkv_w0[l], rwkv_w2[l], rwkv_a0[l], rwkv_a2[l], rwkv_g2[l],
                         rwkv_k_k[l], rwkv_k_a[l], rwkv_r_k[l], rwkv_ln_w[l], rwkv_ln_b[l], w_out_b[l],
                         lb[l], hgrn_norm_w[l], w_out_c[l], w_out[l])
        h = h + m[5] * y
        u = modulate(rms_norm(h, norm_w[l, 2]), m[6], m[7])
        h = h + 0.5 * m[8] * swiglu(u, ffn_w_gate[l, 1], ffn_w_up[l, 1], ffn_w_down[l, 1])
    return h
```

```cpp
#include <hip/hip_runtime.h>
#include <hip/hip_cooperative_groups.h>
#include <cstdio>
namespace cg = cooperative_groups;

typedef unsigned short u16;
typedef short bf16x8 __attribute__((ext_vector_type(8)));
typedef float f32x4 __attribute__((ext_vector_type(4)));
typedef float f32x2 __attribute__((ext_vector_type(2)));
#define LAS __attribute__((address_space(3)))

constexpr int DM = 1024, NB = 32, SEQ = 2048, NTOK = NB * SEQ, DFF = 2816, PTOT = 8480;
constexpr int LDS_BYTES = 147456 + 16;
#define REP_ATTN 1
#define REP_RWKV 1
#define REP_HGRN 1
#define REP_GEMM 1
#define REP_SYNC 1
#define GSYNC() do { for (int r_ = 0; r_ < REP_SYNC; ++r_) { XcdBarrier xb_; xb_.bar = (unsigned*)(kparams()->ws + WS_BAR); xb_.x = xb_xcc_id(); xb_.st = (volatile LAS unsigned*)(lds + 147456); xcd_barrier(xb_); } } while (0)

constexpr size_t MiB = 1u << 20;
constexpr size_t W_GU0 = 0, W_GU1 = W_GU0 + 5632ull * 1024, W_D0 = W_GU1 + 5632ull * 1024, W_D1 = W_D0 + 1024ull * 2816,
                 W_INA = W_D1 + 1024ull * 2816, W_INB = W_INA + 1536ull * 1024, W_INC = W_INB + 2048ull * 1024, W_G = W_INC + 2048ull * 1024,
                 W_OA = W_G + 3072ull * 1024, W_OB = W_OA + 1024ull * 512, W_OC = W_OB + 1024ull * 512, W_OUT = W_OC + 1024ull * 512,
                 W_LORA = W_OUT + 1024ull * 1024, W_LAYER = W_LORA + 1536ull * 384;
constexpr size_t WS_W = 0, WS_MOD = 120 * MiB, WS_U = 123 * MiB, WS_Z = 251 * MiB, WS_P = 379 * MiB, WS_O = 635 * MiB, WS_LO = 699 * MiB, WS_END = 891 * MiB;
static_assert(W_LAYER * 2 * 2 <= 120 * MiB, "weights fit");
constexpr size_t WS_SS = 891 * MiB, WS_SW = 893 * MiB;
constexpr size_t SW_GU0 = 0, SW_GU1 = 32ull * 5632, SW_INA = 2 * 32ull * 5632, SW_INB = SW_INA + 32ull * 1536, SW_INC = SW_INB + 32ull * 2048, SW_G = SW_INC + 32ull * 2048, SW_LAYER = SW_G + 32ull * 3072;

struct Params { const float* in[30]; float* out; unsigned char* ws; };
typedef const Params __attribute__((address_space(4)))* KP;
__device__ __forceinline__ KP kparams() { KP p = (KP)__builtin_amdgcn_kernarg_segment_ptr(); asm volatile("" : "+s"(p)); return p; }
__device__ __forceinline__ int ltid() { int t = threadIdx.x; asm volatile("" : "+v"(t)); return t; }
__device__ __forceinline__ int lsg(int x) { x = __builtin_amdgcn_readfirstlane(x); asm volatile("" : "+s"(x)); return x; }
__device__ __forceinline__ float shfl_xor_l(float v, int m, int lane) { return __int_as_float(__builtin_amdgcn_ds_bpermute((lane ^ m) << 2, __float_as_int(v))); }
__device__ __forceinline__ bf16x8 as_bf16x8(uint4 v) { return __builtin_bit_cast(bf16x8, v); }

__device__ __forceinline__ unsigned cvt_pk_bf16(float lo, float hi) { unsigned r; asm volatile("s_nop 0\n\tv_cvt_pk_bf16_f32 %0, %1, %2" : "=v"(r) : "v"(lo), "v"(hi)); return r; }
__device__ __forceinline__ float bf2f(u16 h) { return __uint_as_float((unsigned)h << 16); }
__device__ __forceinline__ float bflo(unsigned w) { return __uint_as_float(w << 16); }
__device__ __forceinline__ float bfhi(unsigned w) { return __uint_as_float(w & 0xffff0000u); }
__device__ __forceinline__ u16 f2bf(float f) { return (u16)(cvt_pk_bf16(f, 0.f) & 0xffffu); }
__device__ __forceinline__ float sigmoidf_(float x) { return __builtin_amdgcn_rcpf(1.f + __expf(-x)); }
__device__ __forceinline__ float sigmoid_fast(float x) { return __builtin_amdgcn_rcpf(1.f + __expf(-x)); }
__device__ __forceinline__ float siluf_(float x) { return x * __builtin_amdgcn_rcpf(1.f + __expf(-x)); }
__device__ __forceinline__ float tanhf_(float x) { return 1.f - 2.f * __builtin_amdgcn_rcpf(__expf(2.f * x) + 1.f); }
template <int CTRL> __device__ __forceinline__ float dpp_f(float x) { return __int_as_float(__builtin_amdgcn_update_dpp(0, __float_as_int(x), CTRL, 0xF, 0xF, true)); }
__device__ __forceinline__ float wave_sum(float v) {
    v += dpp_f<0xB1>(v); v += dpp_f<0x4E>(v); v += dpp_f<0x141>(v); v += dpp_f<0x140>(v);
    v += __int_as_float(__builtin_amdgcn_update_dpp(0, __float_as_int(v), 0x142, 0xA, 0xF, false));
    v += __int_as_float(__builtin_amdgcn_update_dpp(0, __float_as_int(v), 0x143, 0xC, 0xF, false));
    return __int_as_float(__builtin_amdgcn_readlane(__float_as_int(v), 63));
}
__device__ __forceinline__ float sum8(float v) { v += dpp_f<0xB1>(v); v += dpp_f<0x4E>(v); v += dpp_f<0x141>(v); return v; }

namespace pg8 {
constexpr int BM = 256, BK = 64, HALF = 128, HTB = HALF * BK * 2, STAGE_BYTES = 8 * HTB, NXCD = 8, WGM = 4;
__host__ __device__ __forceinline__ int lds_byte(int r, int c) { const int st = (r >> 4) * 2 + (c >> 5), rr = r & 15, cc = c & 31, ob = rr * 64 + cc * 2; return st * 1024 + (ob ^ (((ob >> 9) & 1) << 5)); }
__host__ __device__ __forceinline__ void stage_rc(int b, int& R, int& C) { const int st = b / 1024, sb = b % 1024, swz = sb ^ (((sb >> 9) & 1) << 5); R = (st >> 1) * 16 + swz / 64; C = (st & 1) * 32 + (swz % 64) / 2; }
__host__ __device__ __forceinline__ int perm32(int rho) { const int n = rho >> 4, i = rho & 15; return 8 * (i >> 2) + 4 * n + (i & 3); }
struct Unit { int pm, pn; };
struct Gemm { const u16* A; const u16* Bt; int M, N, K; };
struct StaticOrder {
    int nM, nN, nwg, G, c;
    __device__ void init(int M, int N, int G_, int c_) { nM = M / BM; nN = N / BM; nwg = nM * nN; G = G_; c = c_; }
    __device__ bool next(int i, Unit& u) const {
        const long L = (long)i * G + c; if (L >= nwg) return false;
        int wgid = (int)L; { const int q = nwg / NXCD, r = nwg % NXCD, xcd = wgid % NXCD, off = wgid / NXCD; wgid = (xcd < r ? xcd * (q + 1) : r * (q + 1) + (xcd - r) * q) + off; }
        const int nig = WGM * nN, gid = wgid / nig, fm = gid * WGM, gsz = (nM - fm) < WGM ? (nM - fm) : WGM;
        u.pm = fm + ((wgid % nig) % gsz); u.pn = (wgid % nig) / gsz; return true;
    }
};
template <class Epi>
__device__ __forceinline__ void gemm_phase(LAS unsigned char* lds, const Gemm g, const StaticOrder& S, const Epi& E) {
    const int tid = ltid(), wid = __builtin_amdgcn_readfirstlane(tid >> 6), lane = tid & 63, wr = wid >> 2, wc = wid & 3, fr = lane & 15, fq = lane >> 4;
    const int K = g.K, nt = K / BK;
    unsigned voffA[2], voffB[2];
#pragma unroll
    for (int i = 0; i < 2; ++i) { int R, C; stage_rc(tid * 16 + i * 8192, R, C); const int Rb = Epi::PERM ? ((R & ~31) + perm32(R & 31)) : R;
        voffA[i] = (unsigned)(R * K + C) * 2u; voffB[i] = (unsigned)(Rb * K + C) * 2u; }
    const size_t kstep = (size_t)(BK * 2);
    const size_t hstep = (size_t)HALF * K * 2;
    const size_t tstep = 2 * hstep;
    const unsigned ldsw = (unsigned)wid * 1024u;
    const int aoff = lds_byte(wr * 64 + fr, fq * 8), boff = lds_byte(wc * 32 + fr, fq * 8);
#define PG8_SA(b, h) (((b) * 2 + (h)) * HTB)
#define PG8_SB(b, h) ((4 + (b) * 2 + (h)) * HTB)
#define PG8_STAGE(bufoff, gbase, voff) do { _Pragma("unroll") for (int _i = 0; _i < 2; ++_i) \
        __builtin_amdgcn_global_load_lds((const unsigned*)((const char*)(gbase) + (voff)[_i]), (LAS unsigned*)(lds + (bufoff) + ldsw + _i * 8192), 16, 0, 0); } while (0)
#define PG8_LDA(dst, b, h) do { _Pragma("unroll") for (int m = 0; m < 4; ++m) _Pragma("unroll") for (int k = 0; k < 2; ++k) dst[m][k] = *(const LAS bf16x8*)(lds + PG8_SA(b, h) + aoff + m * 2048 + k * 1024); } while (0)
#define PG8_LDB(dst, b, h) do { _Pragma("unroll") for (int n = 0; n < 2; ++n) _Pragma("unroll") for (int k = 0; k < 2; ++k) dst[n][k] = *(const LAS bf16x8*)(lds + PG8_SB(b, h) + boff + n * 2048 + k * 1024); } while (0)
#define PG8_MMA(ai, bj, At, Bt) do { __builtin_amdgcn_s_setprio(1); _Pragma("unroll") for (int m = 0; m < 4; ++m) _Pragma("unroll") for (int n = 0; n < 2; ++n) _Pragma("unroll") for (int k = 0; k < 2; ++k) \
        acc[ai][bj][m][n] = __builtin_amdgcn_mfma_f32_16x16x32_bf16(Bt[n][k], At[m][k], acc[ai][bj][m][n], 0, 0, 0); __builtin_amdgcn_s_setprio(0); } while (0)
#define PG8_WAIT_V(n) asm volatile("s_waitcnt vmcnt(" #n ")" ::: "memory")
#define PG8_WAIT_L(n) asm volatile("s_waitcnt lgkmcnt(" #n ")" ::: "memory")
#define PG8_BAR __builtin_amdgcn_s_barrier()
#define PG8_SCHED __builtin_amdgcn_sched_barrier(0)
    Unit cur, nxt; int ui = 0;
    if (!S.next(0, cur)) return;
    f32x4 acc[2][2][4][2];
#pragma unroll
    for (int a = 0; a < 2; ++a)
#pragma unroll
        for (int b = 0; b < 2; ++b)
#pragma unroll
            for (int m = 0; m < 4; ++m)
#pragma unroll
                for (int n = 0; n < 2; ++n) acc[a][b][m][n] = (f32x4){0.f, 0.f, 0.f, 0.f};
    bf16x8 At[4][2], B0[2][2], B1[2][2];
    const char* cA = (const char*)g.A + (size_t)cur.pm * tstep; const char* cB = (const char*)g.Bt + (size_t)cur.pn * tstep;
    PG8_STAGE(PG8_SB(0, 0), cB, voffB); PG8_STAGE(PG8_SA(0, 0), cA, voffA); PG8_STAGE(PG8_SB(0, 1), cB + hstep, voffB); PG8_STAGE(PG8_SA(0, 1), cA + hstep, voffA);
    if (wr == 1) PG8_BAR;
    PG8_WAIT_V(4); PG8_BAR;
    PG8_STAGE(PG8_SB(1, 0), cB + kstep, voffB); PG8_STAGE(PG8_SA(1, 0), cA + kstep, voffA); PG8_STAGE(PG8_SB(1, 1), cB + hstep + kstep, voffB);
    PG8_WAIT_V(6); PG8_BAR;
    for (;;) {
        const bool has_next = S.next(ui + 1, nxt);
        const char* nA = has_next ? (const char*)g.A + (size_t)nxt.pm * tstep : cA; const char* nB = has_next ? (const char*)g.Bt + (size_t)nxt.pn * tstep : cB;
        for (int t = 0; t < nt; t += 2) {
            const bool last = (t == nt - 2);
            const char* a1 = cA + (size_t)(t + 1) * kstep;
            const char* a2 = last ? nA : cA + (size_t)(t + 2) * kstep; const char* b2 = last ? nB : cB + (size_t)(t + 2) * kstep;
            const char* a3 = a2 + kstep; const char* b3 = b2 + kstep;
            PG8_LDB(B0, 0, 0); PG8_SCHED; PG8_LDA(At, 0, 0); PG8_STAGE(PG8_SA(1, 1), a1 + hstep, voffA);
            PG8_WAIT_L(8); PG8_BAR; PG8_WAIT_L(0); PG8_MMA(0, 0, At, B0); PG8_BAR; PG8_SCHED;
            PG8_LDB(B1, 0, 1); PG8_STAGE(PG8_SB(0, 0), b2, voffB);
            PG8_BAR; PG8_WAIT_L(0); PG8_MMA(0, 1, At, B1); PG8_BAR;
            PG8_LDA(At, 0, 1); PG8_STAGE(PG8_SA(0, 0), a2, voffA);
            PG8_BAR; PG8_WAIT_L(0); PG8_MMA(1, 0, At, B0); PG8_BAR; PG8_SCHED;
            PG8_STAGE(PG8_SB(0, 1), b2 + hstep, voffB);
            PG8_WAIT_V(6); PG8_BAR; PG8_MMA(1, 1, At, B1); PG8_BAR;
            PG8_LDB(B0, 1, 0); PG8_SCHED; PG8_LDA(At, 1, 0); PG8_STAGE(PG8_SA(0, 1), a2 + hstep, voffA);
            PG8_WAIT_L(8); PG8_BAR; PG8_WAIT_L(0); PG8_MMA(0, 0, At, B0); PG8_BAR; PG8_SCHED;
            PG8_LDB(B1, 1, 1); PG8_STAGE(PG8_SB(1, 0), b3, voffB);
            PG8_BAR; PG8_WAIT_L(0); PG8_MMA(0, 1, At, B1); PG8_BAR;
            PG8_LDA(At, 1, 1); PG8_STAGE(PG8_SA(1, 0), a3, voffA);
            PG8_BAR; PG8_WAIT_L(0); PG8_MMA(1, 0, At, B0); PG8_BAR; PG8_SCHED;
            PG8_STAGE(PG8_SB(1, 1), b3 + hstep, voffB);
            PG8_WAIT_V(6); PG8_BAR; PG8_MMA(1, 1, At, B1); PG8_BAR;
        }
        E(acc, cur, wr, wc, fr, fq);
        if (!has_next) break;
#pragma unroll
        for (int a = 0; a < 2; ++a)
#pragma unroll
            for (int b = 0; b < 2; ++b)
#pragma unroll
                for (int m = 0; m < 4; ++m)
#pragma unroll
                    for (int n = 0; n < 2; ++n) acc[a][b][m][n] = (f32x4){0.f, 0.f, 0.f, 0.f};
        cur = nxt; cA = nA; cB = nB; ++ui;
    }
    PG8_WAIT_V(0);
    if (wr == 0) PG8_BAR;
    PG8_BAR;
#undef PG8_SA
#undef PG8_SB
#undef PG8_STAGE
#undef PG8_LDA
#undef PG8_LDB
#undef PG8_MMA
#undef PG8_WAIT_V
#undef PG8_WAIT_L
#undef PG8_BAR
#undef PG8_SCHED
}
}
using pg8::Unit;

__device__ __forceinline__ void load_rstd(const float* ss, int row0, f32x4& ra, f32x4& rb) {
    float t[8];
#pragma unroll
    for (int i = 0; i < 8; ++i) t[i] = ss[row0 + (i >> 2) * 128 + (i & 3) * 16];
#pragma unroll
    for (int i = 0; i < 4; ++i) { ra[i] = __builtin_amdgcn_rsqf(t[i] * (1.f / 1024.f) + 1e-6f); rb[i] = __builtin_amdgcn_rsqf(t[4 + i] * (1.f / 1024.f) + 1e-6f); }
}
struct EpiGU {
    static constexpr bool PERM = true;
    u16* hid; const float* ss; const float* sw;
    __device__ __forceinline__ void operator()(const f32x4 (&acc)[2][2][4][2], const Unit& u, int wr, int wc, int fr, int fq) const {
        const int row0 = u.pm * 256 + wr * 64 + fr, hc0 = u.pn * 128 + wc * 32 + fq * 8;
        const float* swp = sw + (size_t)(u.pm >> 3) * 5632 + u.pn * 256 + wc * 32 + 8 * fq;
        f32x4 ra, rb; load_rstd(ss, row0, ra, rb);
        const f32x4 sg0 = *(const f32x4*)(swp), sg1 = *(const f32x4*)(swp + 4), su0 = *(const f32x4*)(swp + 128), su1 = *(const f32x4*)(swp + 132);
#pragma unroll
        for (int ai = 0; ai < 2; ++ai)
#pragma unroll
            for (int m = 0; m < 4; ++m) { const int r = row0 + ai * 128 + m * 16;
                const float rstd = ai ? rb[m] : ra[m];
                const f32x4 g0 = acc[ai][0][m][0] * rstd + sg0, g1 = acc[ai][0][m][1] * rstd + sg1, u0 = acc[ai][1][m][0] * rstd + su0, u1 = acc[ai][1][m][1] * rstd + su1;
                uint4 st; st.x = cvt_pk_bf16(siluf_(g0[0]) * u0[0], siluf_(g0[1]) * u0[1]); st.y = cvt_pk_bf16(siluf_(g0[2]) * u0[2], siluf_(g0[3]) * u0[3]);
                st.z = cvt_pk_bf16(siluf_(g1[0]) * u1[0], siluf_(g1[1]) * u1[1]); st.w = cvt_pk_bf16(siluf_(g1[2]) * u1[2], siluf_(g1[3]) * u1[3]);
                *(uint4*)(hid + (size_t)r * DFF + hc0) = st; }
    }
};
struct EpiRes {
    static constexpr bool PERM = false;
    const float* hin; float* hout; const float* mv; int ffn;
    u16* hbp; float* ssn; const float* nwn; const float* scn; int has_next;
    __device__ __forceinline__ void operator()(const f32x4 (&acc)[2][2][4][2], const Unit& u, int wr, int wc, int fr, int fq) const {
        const int row0 = u.pm * 256 + wr * 64 + fr, col0 = u.pn * 256 + wc * 32 + 4 * fq;
        const float* mvp = mv + (size_t)(u.pm >> 3) * 9216 + col0;
        const float fac = __builtin_amdgcn_readfirstlane(ffn) ? 0.5f : 1.f;
        const bool hb = __builtin_amdgcn_readfirstlane(has_next) != 0;
        f32x4 rs0 = (f32x4){0.f, 0.f, 0.f, 0.f}, rs1 = rs0;
#pragma unroll
        for (int bj = 0; bj < 2; ++bj)
#pragma unroll
            for (int n = 0; n < 2; ++n) {
                const int co = bj * 128 + n * 16;
                const f32x4 mvv = *(const f32x4*)(mvp + co) * fac;
                f32x4 gn = (f32x4){0.f, 0.f, 0.f, 0.f};
                if (hb) gn = *(const f32x4*)(nwn + col0 + co) * (*(const f32x4*)(scn + (size_t)(u.pm >> 3) * 9216 + col0 + co) + 1.f);
                f32x4 hld[8];
#pragma unroll
                for (int i = 0; i < 8; ++i) hld[i] = *(const f32x4*)(hin + (size_t)(row0 + (i >> 2) * 128 + (i & 3) * 16) * DM + col0 + co);
#pragma unroll
                for (int ai = 0; ai < 2; ++ai)
#pragma unroll
                    for (int m = 0; m < 4; ++m) { const size_t off = (size_t)(row0 + ai * 128 + m * 16) * DM + col0 + co;
                        const f32x4 hv = hld[ai * 4 + m] + mvv * acc[ai][bj][m][n];
                        *(f32x4*)(hout + off) = hv;
                        if (hb) { const float q_ = hv[0] * hv[0] + hv[1] * hv[1] + hv[2] * hv[2] + hv[3] * hv[3]; if (ai == 0) rs0[m] += q_; else rs1[m] += q_;
                            const f32x4 y = hv * gn; uint2 st; st.x = cvt_pk_bf16(y[0], y[1]); st.y = cvt_pk_bf16(y[2], y[3]);
                            *(uint2*)(hbp + off) = st; } }
            }
        if (hb) {
            const int lane = fq * 16 + fr;
#pragma unroll
            for (int i = 0; i < 8; ++i) { float v = (i < 4) ? rs0[i & 3] : rs1[i & 3]; v += shfl_xor_l(v, 16, lane); v += shfl_xor_l(v, 32, lane);
                if (fq == 0) atomicAdd(ssn + row0 + (i >> 2) * 128 + (i & 3) * 16, v); }
        }
    }
};
struct EpiBf16 {
    static constexpr bool PERM = true;
    u16* O; int ldc; const float* ss; const float* sw;
    __device__ __forceinline__ void operator()(const f32x4 (&acc)[2][2][4][2], const Unit& u, int wr, int wc, int fr, int fq) const {
        const int row0 = u.pm * 256 + wr * 64 + fr, col0 = u.pn * 256 + wc * 32 + 8 * fq;
        f32x4 ra = (f32x4){1.f, 1.f, 1.f, 1.f}, rb = ra;
        f32x4 swv[4] = {(f32x4){0.f, 0.f, 0.f, 0.f}, (f32x4){0.f, 0.f, 0.f, 0.f}, (f32x4){0.f, 0.f, 0.f, 0.f}, (f32x4){0.f, 0.f, 0.f, 0.f}};
        if (ss) { load_rstd(ss, row0, ra, rb); const float* swp = sw + (size_t)(u.pm >> 3) * ldc + col0;
            swv[0] = *(const f32x4*)(swp); swv[1] = *(const f32x4*)(swp + 4); swv[2] = *(const f32x4*)(swp + 128); swv[3] = *(const f32x4*)(swp + 132); }
#pragma unroll
        for (int bj = 0; bj < 2; ++bj) {
            const f32x4 s0 = swv[2 * bj], s1 = swv[2 * bj + 1];
#pragma unroll
            for (int ai = 0; ai < 2; ++ai)
#pragma unroll
                for (int m = 0; m < 4; ++m) { const int r = row0 + ai * 128 + m * 16;
                    const float rstd = ai ? rb[m] : ra[m];
                    const f32x4 v0 = acc[ai][bj][m][0] * rstd + s0, v1 = acc[ai][bj][m][1] * rstd + s1;
                    uint4 st; st.x = cvt_pk_bf16(v0[0], v0[1]); st.y = cvt_pk_bf16(v0[2], v0[3]); st.z = cvt_pk_bf16(v1[0], v1[1]); st.w = cvt_pk_bf16(v1[2], v1[3]);
                    *(uint4*)(O + (size_t)r * ldc + col0 + bj * 128) = st; }
        }
    }
};
struct EpiGate {
    static constexpr bool PERM = true;
    u16* Z; const u16* Y; int first; const float* ss; const float* sw;
    __device__ __forceinline__ void operator()(const f32x4 (&acc)[2][2][4][2], const Unit& u, int wr, int wc, int fr, int fq) const {
        const int row0 = u.pm * 256 + wr * 64 + fr, col0 = u.pn * 256 + wc * 32 + 8 * fq;
        f32x4 ra, rb; load_rstd(ss, row0, ra, rb);
        const float* swp = sw + (size_t)(u.pm >> 3) * 3072 + col0;
        const f32x4 swv[4] = {*(const f32x4*)(swp), *(const f32x4*)(swp + 4), *(const f32x4*)(swp + 128), *(const f32x4*)(swp + 132)};
#pragma unroll
        for (int bj = 0; bj < 2; ++bj) {
            const f32x4 s0 = swv[2 * bj], s1 = swv[2 * bj + 1];
#pragma unroll
            for (int ai = 0; ai < 2; ++ai) {
                uint4 yld[4], zld[4];
#pragma unroll
                for (int i = 0; i < 4; ++i) { const size_t off = (size_t)(row0 + ai * 128 + i * 16) * DM + col0 + bj * 128;
                    yld[i] = *(const uint4*)(Y + off); zld[i] = first ? make_uint4(0u, 0u, 0u, 0u) : *(const uint4*)(Z + off); }
#pragma unroll
                for (int m = 0; m < 4; ++m) { const int rr = row0 + ai * 128 + m * 16; const size_t off = (size_t)rr * DM + col0 + bj * 128;
                    const float rstd = ai ? rb[m] : ra[m];
                    const f32x4 v0 = acc[ai][bj][m][0] * rstd + s0, v1 = acc[ai][bj][m][1] * rstd + s1;
                    const uint4 yv = yld[m], zv = zld[m];
                    float r[8];
                    r[0] = sigmoid_fast(v0[0]) * bflo(yv.x); r[1] = sigmoid_fast(v0[1]) * bfhi(yv.x); r[2] = sigmoid_fast(v0[2]) * bflo(yv.y); r[3] = sigmoid_fast(v0[3]) * bfhi(yv.y);
                    r[4] = sigmoid_fast(v1[0]) * bflo(yv.z); r[5] = sigmoid_fast(v1[1]) * bfhi(yv.z); r[6] = sigmoid_fast(v1[2]) * bflo(yv.w); r[7] = sigmoid_fast(v1[3]) * bfhi(yv.w);
                    r[0] += bflo(zv.x); r[1] += bfhi(zv.x); r[2] += bflo(zv.y); r[3] += bfhi(zv.y); r[4] += bflo(zv.z); r[5] += bfhi(zv.z); r[6] += bflo(zv.w); r[7] += bfhi(zv.w);
                    uint4 st; st.x = cvt_pk_bf16(r[0], r[1]); st.y = cvt_pk_bf16(r[2], r[3]); st.z = cvt_pk_bf16(r[4], r[5]); st.w = cvt_pk_bf16(r[6], r[7]);
                    *(uint4*)(Z + off) = st; }
            }
        }
    }
};

__device__ __forceinline__ float w_fetch(KP P, int l, int mat, int n, int k) {
    switch (mat) {
    case 0: case 1: { const int hc = 128 * (n >> 8) + (n & 127); const float* src = (n & 128) ? P->in[7] : P->in[6]; return src[((size_t)(l * 2 + mat) * 1024 + k) * DFF + hc]; }
    case 2: case 3: return P->in[8][((size_t)(l * 2 + (mat - 2)) * DFF + k) * 1024 + n];
    case 4: return P->in[9][((size_t)l * 1024 + k) * PTOT + n];
    case 5: return n < 1824 ? P->in[9][((size_t)l * 1024 + k) * PTOT + 1536 + n] : 0.f;
    case 6: return P->in[9][((size_t)l * 1024 + k) * PTOT + 3360 + n];
    case 7: return P->in[9][((size_t)l * 1024 + k) * PTOT + 5408 + n];
    case 8: return P->in[13][((size_t)l * 512 + k) * 1024 + n];
    case 9: return P->in[25][((size_t)l * 512 + k) * 1024 + n];
    case 10: return P->in[28][((size_t)l * 512 + k) * 1024 + n];
    case 11: return P->in[29][((size_t)l * 1024 + k) * 1024 + n];
    default: {
        if (n < 512) return k < 64 ? P->in[16][((size_t)l * 64 + k) * 512 + n] : 0.f;
        if (n < 1024) return (k >= 64 && k < 128) ? P->in[18][((size_t)l * 64 + (k - 64)) * 512 + (n - 512)] : 0.f;
        return (k >= 128 && k < 288) ? P->in[19][((size_t)l * 160 + (k - 128)) * 512 + (n - 1024)] : 0.f; }
    }
}
__device__ const int kNT[13] = {88, 88, 16, 16, 24, 32, 32, 48, 16, 16, 16, 16, 24};
__device__ const int kKT[13] = {8, 8, 22, 22, 8, 8, 8, 8, 4, 4, 4, 8, 3};
__device__ const unsigned long long kDO[13] = {W_GU0, W_GU1, W_D0, W_D1, W_INA, W_INB, W_INC, W_G, W_OA, W_OB, W_OC, W_OUT, W_LORA};
__device__ __forceinline__ void phase_prologue(KP P, unsigned char* shm) {
    const int tid = ltid();
    float* tile = (float*)shm;
    u16* Wall = (u16*)(P->ws + WS_W);
    constexpr int TPL = 3592;
    {
        const int nn = tid & 63, kq = tid >> 6;
        int l = 0, mat = 0, n0 = 0, k0 = 0, K = 0; size_t dofs = 0;
        float v[16];
#define PRO_DEC(t_) do { l = (t_) / TPL; int r_ = (t_) % TPL; mat = 0; \
            while (r_ >= kNT[mat] * kKT[mat]) { r_ -= kNT[mat] * kKT[mat]; ++mat; } \
            const int kT_ = kKT[mat]; dofs = (size_t)kDO[mat]; \
            n0 = (r_ / kT_) * 64; k0 = (r_ % kT_) * 128; K = kT_ * 128; \
            l = __builtin_amdgcn_readfirstlane(l); mat = __builtin_amdgcn_readfirstlane(mat); n0 = __builtin_amdgcn_readfirstlane(n0); k0 = __builtin_amdgcn_readfirstlane(k0); K = __builtin_amdgcn_readfirstlane(K); \
            _Pragma("unroll") for (int i = 0; i < 16; ++i) v[i] = w_fetch(P, l, mat, n0 + nn, k0 + kq + 8 * i); } while (0)
        int t = blockIdx.x, buf = 0;
        if (t < 2 * TPL) PRO_DEC(t);
        while (t < 2 * TPL) {
            float* tl_ = tile + buf * (128 * 65);
#pragma unroll
            for (int i = 0; i < 16; ++i) tl_[(kq + 8 * i) * 65 + nn] = v[i];
            u16* dst = Wall + (size_t)l * W_LAYER + dofs + (size_t)(n0 + (tid >> 3)) * K + k0 + (tid & 7) * 16;
            const int tn = t + gridDim.x;
            if (tn < 2 * TPL) PRO_DEC(tn);
            __syncthreads();
            { const int n2 = tid >> 3, ks = tid & 7; float o[16];
#pragma unroll
              for (int j = 0; j < 16; ++j) o[j] = tl_[(ks * 16 + j) * 65 + n2];
              uint4 st0, st1; st0.x = cvt_pk_bf16(o[0], o[1]); st0.y = cvt_pk_bf16(o[2], o[3]); st0.z = cvt_pk_bf16(o[4], o[5]); st0.w = cvt_pk_bf16(o[6], o[7]);
              st1.x = cvt_pk_bf16(o[8], o[9]); st1.y = cvt_pk_bf16(o[10], o[11]); st1.z = cvt_pk_bf16(o[12], o[13]); st1.w = cvt_pk_bf16(o[14], o[15]);
              *(uint4*)dst = st0; *(uint4*)(dst + 8) = st1; }
            buf ^= 1; t = tn;
        }
#undef PRO_DEC
        __syncthreads();
    }
    { float* ssz = (float*)(P->ws + WS_SS); for (int i = blockIdx.x * 512 + tid; i < 6 * NTOK; i += gridDim.x * 512) ssz[i] = 0.f; }
    float* condT = (float*)shm;
    float* red = (float*)shm;
    float* modo = (float*)(P->ws + WS_MOD);
    const int wave = tid >> 6, lane = tid & 63;
    for (int it = blockIdx.x; it < 288; it += gridDim.x) {
        const int l = it / 144, cg0 = (it % 144) * 64;
        for (int i = tid; i < 32768; i += 512) { const int b = i >> 10, k = i & 1023; condT[k * 32 + b] = siluf_(P->in[1][i]); }
        __syncthreads();
        float acc[32];
#pragma unroll
        for (int b = 0; b < 32; ++b) acc[b] = 0.f;
        const float* wp = P->in[3] + ((size_t)l * 1024 + wave * 128) * 9216 + cg0 + lane;
        for (int k = 0; k < 128; k += 8) {
            float w8[8];
#pragma unroll
            for (int j = 0; j < 8; ++j) w8[j] = wp[(size_t)(k + j) * 9216];
#pragma unroll
            for (int j = 0; j < 8; ++j) { const float w = w8[j];
                const f32x4* cp = (const f32x4*)(condT + (wave * 128 + k + j) * 32);
#pragma unroll
                for (int q = 0; q < 8; ++q) { const f32x4 c4 = cp[q]; acc[q * 4 + 0] += c4[0] * w; acc[q * 4 + 1] += c4[1] * w; acc[q * 4 + 2] += c4[2] * w; acc[q * 4 + 3] += c4[3] * w; } }
        }
        __syncthreads();
#pragma unroll
        for (int b = 0; b < 32; ++b) red[(wave * 32 + b) * 64 + lane] = acc[b];
        __syncthreads();
#pragma unroll
        for (int i = 0; i < 4; ++i) { const int o = tid + 512 * i, b = o >> 6, cl = o & 63; float s = P->in[4][(size_t)l * 9216 + cg0 + cl];
#pragma unroll
            for (int w = 0; w < 8; ++w) s += red[(w * 32 + b) * 64 + cl];
            modo[((size_t)l * 32 + b) * 9216 + cg0 + cl] = s; }
        __syncthreads();
    }
}

__device__ __forceinline__ void phase_norm0_sw(KP P, unsigned char* shm) {
    const int tid = ltid(), lane = tid & 63, wave = tid >> 6, gw = blockIdx.x * 8 + wave, nw = gridDim.x * 8;
    const float* modall = (const float*)(P->ws + WS_MOD);
    {
        const float* nwp = P->in[5];
        u16* U = (u16*)(P->ws + WS_U);
        float* ss0 = (float*)(P->ws + WS_SS);
        const float* h = P->in[0];
        f32x4 wv[4];
#pragma unroll
        for (int i = 0; i < 4; ++i) wv[i] = *(const f32x4*)(nwp + 4 * (lane + 64 * i));
        for (int rowb = gw; rowb < NTOK; rowb += 2 * nw) {
            f32x4 v[2][4];
#pragma unroll
            for (int rr = 0; rr < 2; ++rr) { const int row = rowb + rr * nw; if (row < NTOK) {
#pragma unroll
                for (int i = 0; i < 4; ++i) v[rr][i] = *(const f32x4*)(h + (size_t)row * DM + 4 * (lane + 64 * i)); } }
#pragma unroll
            for (int rr = 0; rr < 2; ++rr) { const int row = rowb + rr * nw; if (row < NTOK) {
                const float* scp = modall + (size_t)(row >> 11) * 9216 + 1024;
                float ss = 0.f;
#pragma unroll
                for (int i = 0; i < 4; ++i) ss += v[rr][i][0] * v[rr][i][0] + v[rr][i][1] * v[rr][i][1] + v[rr][i][2] * v[rr][i][2] + v[rr][i][3] * v[rr][i][3];
                ss = wave_sum(ss);
                if (lane == 0) ss0[row] = ss;
#pragma unroll
                for (int i = 0; i < 4; ++i) { const int c = 4 * (lane + 64 * i);
                    const f32x4 y = v[rr][i] * wv[i] * (*(const f32x4*)(scp + c) + 1.f);
                    uint2 st; st.x = cvt_pk_bf16(y[0], y[1]); st.y = cvt_pk_bf16(y[2], y[3]);
                    *(uint2*)(U + (size_t)row * DM + c) = st; } } }
        }
    }
    __syncthreads();
    float* shT = (float*)shm;
    float* red = (float*)shm;
    float* SWall = (float*)(P->ws + WS_SW);
    const int MATS[6] = {0, 1, 4, 5, 6, 7}, GRP[6] = {88, 88, 24, 32, 32, 48}, NN[6] = {5632, 5632, 1536, 2048, 2048, 3072};
    const size_t SO[6] = {SW_GU0, SW_GU1, SW_INA, SW_INB, SW_INC, SW_G};
    for (int it = blockIdx.x; it < 624; it += gridDim.x) {
        const int l = it / 312; int r = it % 312, mi = 0;
#pragma unroll
        for (int i = 0; i < 6; ++i) if (mi == i && r >= GRP[i]) { r -= GRP[i]; mi = i + 1; }
        int mat = 0, N = 0; size_t so = 0;
#pragma unroll
        for (int i = 0; i < 6; ++i) if (mi == i) { mat = MATS[i]; N = NN[i]; so = SO[i]; }
        const int sub = mat == 0 ? 0 : (mat == 1 ? 2 : 1), n0 = r * 64;
        const float* shp = modall + (size_t)l * 32 * 9216 + (3 * sub) * 1024;
        for (int i = tid; i < 32768; i += 512) { const int b = i >> 10, k = i & 1023; shT[k * 32 + b] = shp[(size_t)b * 9216 + k]; }
        __syncthreads();
        float acc[32];
#pragma unroll
        for (int b = 0; b < 32; ++b) acc[b] = 0.f;
        for (int k = 0; k < 128; k += 8) {
            float w8[8];
#pragma unroll
            for (int j = 0; j < 8; ++j) w8[j] = w_fetch(P, l, mat, n0 + lane, wave * 128 + k + j);
#pragma unroll
            for (int j = 0; j < 8; ++j) { const float w = w8[j];
                const f32x4* cp = (const f32x4*)(shT + (wave * 128 + k + j) * 32);
#pragma unroll
                for (int q = 0; q < 8; ++q) { const f32x4 c4 = cp[q]; acc[q * 4 + 0] += c4[0] * w; acc[q * 4 + 1] += c4[1] * w; acc[q * 4 + 2] += c4[2] * w; acc[q * 4 + 3] += c4[3] * w; } }
        }
        __syncthreads();
#pragma unroll
        for (int b = 0; b < 32; ++b) red[(wave * 32 + b) * 64 + lane] = acc[b];
        __syncthreads();
        float* dst = SWall + (size_t)l * SW_LAYER + so;
#pragma unroll
        for (int i = 0; i < 4; ++i) { const int o = tid + 512 * i, b = o >> 6, cl = o & 63; float sum = 0.f;
#pragma unroll
            for (int w = 0; w < 8; ++w) sum += red[(w * 32 + b) * 64 + cl];
            dst[(size_t)b * N + n0 + cl] = sum; }
        __syncthreads();
    }
}

__device__ const double kInvRev[32] = {0.15915494309189535, 0.11934937021124886, 0.08949940160889101, 0.06711508300522726, 0.050329212104487035, 0.03774158471741977, 0.0283021958306234, 0.02122365276477766, 0.015915494309189534, 0.011934937021124886, 0.008949940160889102, 0.006711508300522725, 0.005032921210448704, 0.003774158471741977, 0.00283021958306234, 0.0021223652764777662, 0.0015915494309189536, 0.0011934937021124885, 0.0008949940160889102, 0.0006711508300522726, 0.0005032921210448703, 0.00037741584717419774, 0.00028302195830623395, 0.0002122365276477766, 0.00015915494309189535, 0.00011934937021124886, 8.949940160889102e-05, 6.711508300522725e-05, 5.0329212104487035e-05, 3.774158471741978e-05, 2.8302195830623396e-05, 2.122365276477766e-05};
__device__ __forceinline__ void phase_attn_prep(KP P, int l_, unsigned char* shm) {
    const int l = lsg(l_);
    const int tid_ = ltid(), lane = tid_ & 63, gw = blockIdx.x * 8 + (tid_ >> 6), nw = gridDim.x * 8;
    u16* pA = (u16*)(P->ws + WS_P);
    const int vi = lane >> 2, sq = lane & 3;
    const float* qkw = P->in[10] + (size_t)(l * 2 + (vi >> 3)) * 64 + sq * 8;
    float w1[8], w2[8];
#pragma unroll
    for (int j = 0; j < 8; ++j) { w1[j] = qkw[j]; w2[j] = qkw[32 + j]; }
    const float qs = (vi < 8) ? 0.125f * 1.4426950408889634f : 1.f;
    for (int rowb = gw; rowb < NTOK; rowb += 2 * nw) {
      uint4 la[2], lb[2]; int lpos[2];
#pragma unroll
      for (int i = 0; i < 2; ++i) { const int row = rowb + i * nw; if (row < NTOK) { const u16* p = pA + (size_t)row * 1536 + vi * 64 + sq * 8; la[i] = *(const uint4*)p; lb[i] = *(const uint4*)(p + 32); lpos[i] = ((const int*)P->in[2])[row]; } }
#pragma unroll
      for (int i = 0; i < 2; ++i) { const int row = rowb + i * nw; if (row < NTOK) {
        u16* p = pA + (size_t)row * 1536 + vi * 64 + sq * 8;
        const uint4 a = la[i], bq = lb[i];
        float t1[8] = {bflo(a.x), bfhi(a.x), bflo(a.y), bfhi(a.y), bflo(a.z), bfhi(a.z), bflo(a.w), bfhi(a.w)};
        float t2[8] = {bflo(bq.x), bfhi(bq.x), bflo(bq.y), bfhi(bq.y), bflo(bq.z), bfhi(bq.z), bflo(bq.w), bfhi(bq.w)};
        float ss = 0.f;
#pragma unroll
        for (int j = 0; j < 8; ++j) ss += t1[j] * t1[j] + t2[j] * t2[j];
        ss += dpp_f<0xB1>(ss); ss += dpp_f<0x4E>(ss);
        const float rstd = __builtin_amdgcn_rsqf(ss * (1.f / 64.f) + 1e-6f) * qs;
        const double pos = (double)lpos[i];
        float o1[8], o2[8];
#pragma unroll
        for (int j = 0; j < 8; ++j) {
            const double rev = pos * kInvRev[sq * 8 + j];
            const float fr = (float)(rev - rint(rev));
            const float sn = __builtin_amdgcn_sinf(fr), cs = __builtin_amdgcn_cosf(fr);
            const float n1 = t1[j] * rstd * w1[j], n2 = t2[j] * rstd * w2[j];
            o1[j] = n1 * cs - n2 * sn; o2[j] = n2 * cs + n1 * sn;
        }
        uint4 s1, s2;
        s1.x = cvt_pk_bf16(o1[0], o1[1]); s1.y = cvt_pk_bf16(o1[2], o1[3]); s1.z = cvt_pk_bf16(o1[4], o1[5]); s1.w = cvt_pk_bf16(o1[6], o1[7]);
        s2.x = cvt_pk_bf16(o2[0], o2[1]); s2.y = cvt_pk_bf16(o2[2], o2[3]); s2.z = cvt_pk_bf16(o2[4], o2[5]); s2.w = cvt_pk_bf16(o2[6], o2[7]);
        *(uint4*)p = s1; *(uint4*)(p + 32) = s2;
      } }
    }
    {
        u16* vT = (u16*)(P->ws + WS_LO);
        u16* tile = (u16*)shm;
        const int ts = tid_ >> 3, tc = tid_ & 7;
        const int te = tid_ >> 2, tq = tid_ & 3;
        uint4 a0 = make_uint4(0u, 0u, 0u, 0u), a1 = a0;
#define VT_LOAD(it_) do { const int bh_ = (it_) >> 5, sb_ = (it_) & 31; \
            const u16* src_ = pA + ((size_t)(bh_ >> 2) * SEQ + sb_ * 64 + ts) * 1536 + 1024 + (bh_ & 3) * 128 + tc * 16; \
            a0 = *(const uint4*)src_; a1 = *(const uint4*)(src_ + 8); } while (0)
        if ((int)blockIdx.x < 4096) VT_LOAD(blockIdx.x);
        for (int it = blockIdx.x; it < 4096; it += gridDim.x) {
            const int bh = it >> 5, sb = it & 31;
            *(uint4*)(tile + ts * 136 + tc * 16) = a0; *(uint4*)(tile + ts * 136 + tc * 16 + 8) = a1;
            if (it + (int)gridDim.x < 4096) VT_LOAD(it + gridDim.x);
            __syncthreads();
            unsigned w[8];
#pragma unroll
            for (int j = 0; j < 8; ++j) w[j] = (unsigned)tile[(tq * 16 + 2 * j) * 136 + te] | ((unsigned)tile[(tq * 16 + 2 * j + 1) * 136 + te] << 16);
            u16* dst = vT + ((size_t)bh * 128 + te) * SEQ + sb * 64 + tq * 16;
            uint4 o0, o1; o0.x = w[0]; o0.y = w[1]; o0.z = w[2]; o0.w = w[3]; o1.x = w[4]; o1.y = w[5]; o1.z = w[6]; o1.w = w[7];
            *(uint4*)dst = o0; *(uint4*)(dst + 8) = o1;
            __syncthreads();
        }
#undef VT_LOAD
    }
}

__device__ __forceinline__ void phase_attn(KP P, int l_, unsigned char* shm) {
    const int l = lsg(l_);
    const int tid = ltid(), wave = tid >> 6, lane = tid & 63, mp = wave >> 2, rq = wave & 3, l15 = lane & 15, g = lane >> 4;
    const u16* pA = (const u16*)(P->ws + WS_P);
    u16* OA = (u16*)(P->ws + WS_O);
    constexpr int KROW = 72, VROW = 136, KT_B = 128 * KROW * 2, VT_B = 128 * VROW * 2, STG = 2 * KT_B + VT_B;
    const u16* vTg = (const u16*)(P->ws + WS_LO);
    const float lam_init = 0.8f - 0.6f * __expf(-0.3f * (float)l);
    float lam;
    { const float* lq = P->in[11] + (size_t)l * 256; const float s1 = wave_sum(lq[lane] * lq[64 + lane]), s2 = wave_sum(lq[128 + lane] * lq[192 + lane]); lam = __expf(s1) - __expf(s2) + lam_init; }
    for (int it = blockIdx.x; it < 4096; it += gridDim.x) {
        const int j = it & 255, pi = 15 - (it >> 8), bh = j >> 1, half = j & 1, b = bh >> 2, h = bh & 3;
        const int qb = (pi >> 1) * 4 + ((pi & 1) ? (half ? 2 : 3) : (half ? 1 : 0));
        const int q0 = qb * 64, nt = (qb >> 1) + 1;
        const size_t tok0 = (size_t)b * SEQ;
        bf16x8 qf[2];
        { const u16* qp = pA + (tok0 + q0 + rq * 16 + l15) * 1536 + h * 128 + mp * 64 + g * 8;
          qf[0] = *(const bf16x8*)qp; qf[1] = *(const bf16x8*)(qp + 32); }
        f32x4 ot[8];
#pragma unroll
        for (int e = 0; e < 8; ++e) ot[e] = (f32x4){0.f, 0.f, 0.f, 0.f};
        float mrun = -INFINITY, lrun = 0.f;
        uint4 kreg0, kreg1, kreg2, kreg3, vreg0, vreg1, vreg2, vreg3;
        const int kc_key = (tid >> 3) & 63, kc_ch = tid & 7, vc_e = tid >> 4, vc_ch = tid & 15;
        const u16* kgb = pA + (tok0 + kc_key) * 1536 + 512 + h * 128 + kc_ch * 8;
        const u16* vTb = vTg + ((size_t)bh * 128 + vc_e) * SEQ + vc_ch * 8;
#define ATT_GLOAD(t_) do { const u16* kp_ = kgb + (size_t)(t_) * 128 * 1536; \
            kreg0 = *(const uint4*)(kp_); kreg1 = *(const uint4*)(kp_ + (size_t)64 * 1536); kreg2 = *(const uint4*)(kp_ + 64); kreg3 = *(const uint4*)(kp_ + (size_t)64 * 1536 + 64); \
            const u16* vp_ = vTb + (size_t)(t_) * 128; \
            vreg0 = *(const uint4*)(vp_); vreg1 = *(const uint4*)(vp_ + (size_t)32 * SEQ); vreg2 = *(const uint4*)(vp_ + (size_t)64 * SEQ); vreg3 = *(const uint4*)(vp_ + (size_t)96 * SEQ); } while (0)
#define ATT_LSTORE(st_) do { unsigned char* base_ = shm + (st_) * STG; \
            u16* k0_ = (u16*)base_ + kc_key * KROW + kc_ch * 8; \
            *(uint4*)k0_ = kreg0; *(uint4*)(k0_ + 64 * KROW) = kreg1; *(uint4*)(k0_ + 128 * KROW) = kreg2; *(uint4*)(k0_ + 192 * KROW) = kreg3; \
            u16* vt_ = (u16*)(base_ + 2 * KT_B) + vc_e * VROW + vc_ch * 8; \
            *(uint4*)vt_ = vreg0; *(uint4*)(vt_ + 32 * VROW) = vreg1; *(uint4*)(vt_ + 64 * VROW) = vreg2; *(uint4*)(vt_ + 96 * VROW) = vreg3; } while (0)
        ATT_GLOAD(0); ATT_LSTORE(0); __syncthreads();
        for (int t = 0; t < nt; ++t) {
            if (t + 1 < nt) ATT_GLOAD(t + 1);
            const unsigned char* base = shm + (t & 1) * STG;
#pragma unroll
            for (int hf = 0; hf < 2; ++hf) {
                const int kb = 2 * t + hf;
                if (kb <= qb) {
                    const u16* Ks = (const u16*)(base + mp * KT_B) + hf * 64 * KROW;
                    const u16* Vt = (const u16*)(base + 2 * KT_B) + hf * 64;
                    f32x4 st[4];
                    bf16x8 kfr[4][2];
#pragma unroll
                    for (int kt = 0; kt < 4; ++kt)
#pragma unroll
                        for (int ks = 0; ks < 2; ++ks) kfr[kt][ks] = *(const bf16x8*)(Ks + (kt * 16 + l15) * KROW + ks * 32 + g * 8);
                    uint2 vfa[8][2], vfb[8][2];
#pragma unroll
                    for (int e = 0; e < 8; ++e)
#pragma unroll
                        for (int k2 = 0; k2 < 2; ++k2) { const u16* vp = Vt + (e * 16 + l15) * VROW + k2 * 32 + g * 4; vfa[e][k2] = *(const uint2*)vp; vfb[e][k2] = *(const uint2*)(vp + 16); }
                    __builtin_amdgcn_sched_barrier(0);
#pragma unroll
                    for (int kt = 0; kt < 4; ++kt) { st[kt] = (f32x4){0.f, 0.f, 0.f, 0.f};
#pragma unroll
                        for (int ks = 0; ks < 2; ++ks) st[kt] = __builtin_amdgcn_mfma_f32_16x16x32_bf16(kfr[kt][ks], qf[ks], st[kt], 0, 0, 0); }
                    if (kb == qb) {
                        asm volatile("" ::: "memory");
                        const int qr = rq * 16 + l15;
#pragma unroll
                        for (int kt = 0; kt < 4; ++kt)
#pragma unroll
                            for (int jj = 0; jj < 4; ++jj) if (kt * 16 + g * 4 + jj > qr) st[kt][jj] = -INFINITY;
                    }
                    float mloc = st[0][0];
#pragma unroll
                    for (int kt = 0; kt < 4; ++kt)
#pragma unroll
                        for (int jj = 0; jj < 4; ++jj) mloc = fmaxf(mloc, st[kt][jj]);
                    mloc = fmaxf(mloc, shfl_xor_l(mloc, 16, lane)); mloc = fmaxf(mloc, shfl_xor_l(mloc, 32, lane));
                    const float mnew = fmaxf(mrun, mloc), alpha = __builtin_amdgcn_exp2f(mrun - mnew);
                    mrun = mnew;
                    float psum = 0.f;
#pragma unroll
                    for (int kt = 0; kt < 4; ++kt)
#pragma unroll
                        for (int jj = 0; jj < 4; ++jj) { const float p = __builtin_amdgcn_exp2f(st[kt][jj] - mnew); st[kt][jj] = p; psum += p; }
                    lrun = lrun * alpha + psum;
#pragma unroll
                    for (int e = 0; e < 8; ++e) ot[e] *= alpha;
                    bf16x8 pb[2];
#pragma unroll
                    for (int k2 = 0; k2 < 2; ++k2) { uint4 pk; pk.x = cvt_pk_bf16(st[2 * k2][0], st[2 * k2][1]); pk.y = cvt_pk_bf16(st[2 * k2][2], st[2 * k2][3]);
                        pk.z = cvt_pk_bf16(st[2 * k2 + 1][0], st[2 * k2 + 1][1]); pk.w = cvt_pk_bf16(st[2 * k2 + 1][2], st[2 * k2 + 1][3]);
                        pb[k2] = as_bf16x8(pk); }
#pragma unroll
                    for (int e = 0; e < 8; ++e)
#pragma unroll
                        for (int k2 = 0; k2 < 2; ++k2) { const uint2 v0 = vfa[e][k2], v1 = vfb[e][k2];
                            uint4 vv; vv.x = v0.x; vv.y = v0.y; vv.z = v1.x; vv.w = v1.y;
                            ot[e] = __builtin_amdgcn_mfma_f32_16x16x32_bf16(as_bf16x8(vv), pb[k2], ot[e], 0, 0, 0); }
                }
            }
            if (t + 1 < nt) ATT_LSTORE((t + 1) & 1);
            __syncthreads();
        }
#undef ATT_GLOAD
#undef ATT_LSTORE
        lrun += shfl_xor_l(lrun, 16, lane); lrun += shfl_xor_l(lrun, 32, lane);
        const float inv = __builtin_amdgcn_rcpf(lrun);
        float* X = (float*)shm;
        if (mp == 1) {
#pragma unroll
            for (int e = 0; e < 8; ++e)
#pragma unroll
                for (int jj = 0; jj < 4; ++jj) X[(rq * 128 + e * 16 + g * 4 + jj) * 16 + l15] = ot[e][jj] * inv * lam;
        }
        __syncthreads();
        if (mp == 0) {
            float ss = 0.f;
#pragma unroll
            for (int e = 0; e < 8; ++e)
#pragma unroll
                for (int jj = 0; jj < 4; ++jj) { const float o = ot[e][jj] * inv - X[(rq * 128 + e * 16 + g * 4 + jj) * 16 + l15]; ot[e][jj] = o; ss += o * o; }
            ss += shfl_xor_l(ss, 16, lane); ss += shfl_xor_l(ss, 32, lane);
            const float rstd = __builtin_amdgcn_rsqf(ss * (1.f / 128.f) + 1e-6f) * (1.f - lam_init);
            const float* sw = P->in[12] + (size_t)l * 128;
            u16* op = OA + (tok0 + q0 + rq * 16 + l15) * 512 + h * 128;
#pragma unroll
            for (int e = 0; e < 8; ++e) { const int e0 = e * 16 + g * 4; const f32x4 w4 = *(const f32x4*)(sw + e0);
                uint2 stv; stv.x = cvt_pk_bf16(ot[e][0] * rstd * w4[0], ot[e][1] * rstd * w4[1]); stv.y = cvt_pk_bf16(ot[e][2] * rstd * w4[2], ot[e][3] * rstd * w4[3]);
                *(uint2*)(op + e0) = stv; }
        }
        __syncthreads();
    }
}

__device__ __forceinline__ void phase_lora_prep(KP P, int l_) {
    const int l = lsg(l_);
    const int tid_ = ltid(), lane = tid_ & 63, gw = blockIdx.x * 8 + (tid_ >> 6), nw = gridDim.x * 8;
    const u16* pB = (const u16*)(P->ws + WS_P);
    unsigned* Ap = (unsigned*)(P->ws + WS_O);
    const float* mu = P->in[14] + (size_t)l * 1824 + 1536;
    float mu0[3], mu1[3];
#pragma unroll
    for (int q = 0; q < 3; ++q) { const int c = 2 * (lane + 64 * q); mu0[q] = c < 288 ? mu[c] : 0.f; mu1[q] = c < 288 ? mu[c + 1] : 0.f; }
    for (int row0 = gw * 4; row0 < NTOK; row0 += nw * 4) {
        unsigned ld[5][3];
#pragma unroll
        for (int r = 0; r < 5; ++r)
#pragma unroll
            for (int q = 0; q < 3; ++q) { const int c = 2 * (lane + 64 * q); const int row = row0 - 1 + r;
                ld[r][q] = (c < 288 && (r > 0 || (row0 & 2047) != 0)) ? *(const unsigned*)(pB + (size_t)row * 2048 + 1536 + c) : 0u; }
#pragma unroll
        for (int r = 1; r < 5; ++r)
#pragma unroll
            for (int q = 0; q < 3; ++q) { const int c = 2 * (lane + 64 * q);
                unsigned outw = 0u;
                if (c < 288) { const unsigned cur = ld[r][q], prv = ld[r - 1][q];
                    float x0 = bflo(cur), x1 = bfhi(cur);
                    x0 += (bflo(prv) - x0) * mu0[q]; x1 += (bfhi(prv) - x1) * mu1[q];
                    if (c < 64) { x0 = tanhf_(x0); x1 = tanhf_(x1); } else if (c >= 128) { x0 = sigmoidf_(x0); x1 = sigmoidf_(x1); }
                    outw = cvt_pk_bf16(x0, x1); }
                Ap[(size_t)(row0 - 1 + r) * 192 + lane + 64 * q] = outw; }
    }
}

__device__ __forceinline__ void phase_rwkv(KP P, int l_, unsigned char* shm) {
    const int l = lsg(l_);
    const int tid = ltid(), wave = __builtin_amdgcn_readfirstlane(tid >> 6), lane = tid & 63;
    const int rp = (tid & 255) >> 3, seg = tid & 7, pw = wave & 3;
    const bool scanw = wave < 4;
    const u16* pB = (const u16*)(P->ws + WS_P);
    const u16* LO = (const u16*)(P->ws + WS_LO);
    u16* OB = (u16*)(P->ws + WS_O);
    constexpr int T = 32, NC = SEQ / T, CS = 5 * T * 64;
    float* sCoef = (float*)shm;
    float* sV = sCoef + 2 * CS;
    float* sG = sV + 3 * T * 64;
    float* sO = sG + 2 * T * 64;
    float* sBon = sO + 2 * T * 64;
    for (int bh = blockIdx.x; bh < 256; bh += gridDim.x) {
        const int b = bh >> 3, h = bh & 7, ch = h * 64 + lane;
        const float mu_r = P->in[14][(size_t)l * 1824 + ch], mu_k = P->in[14][(size_t)l * 1824 + 512 + ch], mu_v = P->in[14][(size_t)l * 1824 + 1024 + ch];
        const float kkw = P->in[20][(size_t)l * 512 + ch], kaw = P->in[21][(size_t)l * 512 + ch], rkw = P->in[22][(size_t)l * 512 + ch];
        const float lnw = P->in[23][(size_t)l * 512 + ch], lnb = P->in[24][(size_t)l * 512 + ch];
        const float w0c = P->in[15][(size_t)l * 512 + ch], a0c = P->in[17][(size_t)l * 512 + ch];
        f32x2 sa[4], sb[4];
#pragma unroll
        for (int jj = 0; jj < 4; ++jj) { sa[jj] = (f32x2){0.f, 0.f}; sb[jj] = (f32x2){0.f, 0.f}; }
        unsigned short gr[9], gk[9], gv[9], gw[8], ga[8], gg[8];
#define RW_LOAD(c_) do { const int tb_ = (c_) * T + pw * 8; \
            _Pragma("unroll") for (int i = 0; i < 9; ++i) { const int t_ = tb_ + i - 1; \
                if (t_ >= 0) { const u16* pc_ = pB + ((size_t)b * SEQ + t_) * 2048 + ch; gr[i] = pc_[0]; gk[i] = pc_[512]; gv[i] = pc_[1024]; } else { gr[i] = 0; gk[i] = 0; gv[i] = 0; } } \
            _Pragma("unroll") for (int i = 0; i < 8; ++i) { const u16* lp_ = LO + ((size_t)b * SEQ + tb_ + i) * 1536 + ch; gw[i] = lp_[0]; ga[i] = lp_[512]; gg[i] = lp_[1024]; } } while (0)
#define RW_PREP(c_) do { float* cf_ = sCoef + ((c_) & 1) * CS; float* vv_ = sV + ((c_) % 3) * T * 64; float* gg_ = sG + ((c_) & 1) * T * 64; \
            _Pragma("unroll") for (int i = 0; i < 8; ++i) { const int tl_ = pw * 8 + i; \
                float r_ = bf2f(gr[i + 1]), k_ = bf2f(gk[i + 1]), v_ = bf2f(gv[i + 1]); \
                r_ += (bf2f(gr[i]) - r_) * mu_r; k_ += (bf2f(gk[i]) - k_) * mu_k; v_ += (bf2f(gv[i]) - v_) * mu_v; \
                const float dec_ = __expf(-0.60653066f * sigmoidf_(w0c + bf2f(gw[i]))); \
                const float a_ = sigmoidf_(a0c + bf2f(ga[i])); \
                const float kr_ = k_ * kkw; \
                const float kk_ = kr_ * __builtin_amdgcn_rsqf(fmaxf(wave_sum(kr_ * kr_), 1e-24f));     \
                const float km_ = k_ * (1.f + (a_ - 1.f) * kaw); \
                const float bon_ = wave_sum(r_ * km_ * rkw); \
                cf_[tl_ * 64 + lane] = dec_; cf_[T * 64 + tl_ * 64 + lane] = kk_; cf_[2 * T * 64 + tl_ * 64 + lane] = kk_ * a_; cf_[3 * T * 64 + tl_ * 64 + lane] = km_; cf_[4 * T * 64 + tl_ * 64 + lane] = r_; \
                vv_[tl_ * 64 + lane] = v_; gg_[tl_ * 64 + lane] = bf2f(gg[i]); \
                if (lane == 0) sBon[((c_) % 3) * T + tl_] = bon_; } } while (0)
#define RW_POST(c_) do { const float* vv_ = sV + ((c_) % 3) * T * 64; const float* gg_ = sG + ((c_) & 1) * T * 64; const float* oo_ = sO + ((c_) & 1) * T * 64; \
            _Pragma("unroll") for (int i = 0; i < 8; ++i) { const int tl_ = pw * 8 + i; const size_t tok_ = (size_t)b * SEQ + (c_) * T + tl_; \
                const float o_ = oo_[tl_ * 64 + lane]; \
                const float mean_ = wave_sum(o_) * (1.f / 64.f); \
                const float dd_ = o_ - mean_; \
                const float var_ = wave_sum(dd_ * dd_) * (1.f / 64.f); \
                float y_ = dd_ * __builtin_amdgcn_rsqf(var_ + 64e-5f) * lnw + lnb; \
                y_ += sBon[((c_) % 3) * T + tl_] * vv_[tl_ * 64 + lane]; \
                OB[tok_ * 512 + ch] = f2bf(y_ * gg_[tl_ * 64 + lane]); } } while (0)
        __syncthreads();
        if (!scanw) { RW_LOAD(0); RW_PREP(0); RW_LOAD(1); }
        __syncthreads();
        for (int c = 0; c < NC; ++c) {
            if (scanw) {
                const float* cf = sCoef + (c & 1) * CS; const float* vb = sV + (c % 3) * T * 64; float* ob = sO + (c & 1) * T * 64;
#define RW_LD(X, tl_) do { const float* q_ = cf + (tl_) * 64 + seg * 8; \
                X##w0 = *(const f32x4*)(q_); X##w1 = *(const f32x4*)(q_ + 4); \
                X##kk0 = *(const f32x4*)(q_ + T * 64); X##kk1 = *(const f32x4*)(q_ + T * 64 + 4); \
                X##b0 = *(const f32x4*)(q_ + 2 * T * 64); X##b1 = *(const f32x4*)(q_ + 2 * T * 64 + 4); \
                X##k0 = *(const f32x4*)(q_ + 3 * T * 64); X##k1 = *(const f32x4*)(q_ + 3 * T * 64 + 4); \
                X##r0 = *(const f32x4*)(q_ + 4 * T * 64); X##r1 = *(const f32x4*)(q_ + 4 * T * 64 + 4); \
                X##va = vb[(tl_) * 64 + rp]; X##vb = vb[(tl_) * 64 + 32 + rp]; } while (0)
#define RW_STEP(X, tl_) do {   \
                const f32x2 kk0l_ = (f32x2){X##kk0[0], X##kk0[1]}, kk0h_ = (f32x2){X##kk0[2], X##kk0[3]}, kk1l_ = (f32x2){X##kk1[0], X##kk1[1]}, kk1h_ = (f32x2){X##kk1[2], X##kk1[3]}; \
                f32x2 da_ = sa[0] * kk0l_ + sa[1] * kk0h_; f32x2 db_ = sb[0] * kk0l_ + sb[1] * kk0h_; \
                f32x2 ea_ = sa[2] * kk1l_ + sa[3] * kk1h_; f32x2 eb_ = sb[2] * kk1l_ + sb[3] * kk1h_; \
                da_ += ea_; db_ += eb_; \
                float ka_ = da_[0] + da_[1], kb_ = db_[0] + db_[1]; \
                ka_ += dpp_f<0xB1>(ka_); kb_ += dpp_f<0xB1>(kb_); ka_ += dpp_f<0x4E>(ka_); kb_ += dpp_f<0x4E>(kb_); ka_ += dpp_f<0x141>(ka_); kb_ += dpp_f<0x141>(kb_); \
                const f32x2 na_ = (f32x2){-ka_, -ka_}, nb_ = (f32x2){-kb_, -kb_}, va_ = (f32x2){X##va, X##va}, vb_ = (f32x2){X##vb, X##vb}; \
                const f32x2 w0l_ = (f32x2){X##w0[0], X##w0[1]}, w0h_ = (f32x2){X##w0[2], X##w0[3]}, w1l_ = (f32x2){X##w1[0], X##w1[1]}, w1h_ = (f32x2){X##w1[2], X##w1[3]}; \
                const f32x2 b0l_ = (f32x2){X##b0[0], X##b0[1]}, b0h_ = (f32x2){X##b0[2], X##b0[3]}, b1l_ = (f32x2){X##b1[0], X##b1[1]}, b1h_ = (f32x2){X##b1[2], X##b1[3]}; \
                const f32x2 k0l_ = (f32x2){X##k0[0], X##k0[1]}, k0h_ = (f32x2){X##k0[2], X##k0[3]}, k1l_ = (f32x2){X##k1[0], X##k1[1]}, k1h_ = (f32x2){X##k1[2], X##k1[3]}; \
                sa[0] = sa[0] * w0l_ + na_ * b0l_ + va_ * k0l_; sb[0] = sb[0] * w0l_ + nb_ * b0l_ + vb_ * k0l_; \
                sa[1] = sa[1] * w0h_ + na_ * b0h_ + va_ * k0h_; sb[1] = sb[1] * w0h_ + nb_ * b0h_ + vb_ * k0h_; \
                sa[2] = sa[2] * w1l_ + na_ * b1l_ + va_ * k1l_; sb[2] = sb[2] * w1l_ + nb_ * b1l_ + vb_ * k1l_; \
                sa[3] = sa[3] * w1h_ + na_ * b1h_ + va_ * k1h_; sb[3] = sb[3] * w1h_ + nb_ * b1h_ + vb_ * k1h_; \
                const f32x2 r0l_ = (f32x2){X##r0[0], X##r0[1]}, r0h_ = (f32x2){X##r0[2], X##r0[3]}, r1l_ = (f32x2){X##r1[0], X##r1[1]}, r1h_ = (f32x2){X##r1[2], X##r1[3]}; \
                f32x2 oa_ = sa[0] * r0l_ + sa[1] * r0h_; f32x2 ob_ = sb[0] * r0l_ + sb[1] * r0h_; \
                f32x2 pa_ = sa[2] * r1l_ + sa[3] * r1h_; f32x2 pb_ = sb[2] * r1l_ + sb[3] * r1h_; \
                oa_ += pa_; ob_ += pb_; \
                float ta_ = oa_[0] + oa_[1], tb_ = ob_[0] + ob_[1]; \
                ta_ += dpp_f<0xB1>(ta_); tb_ += dpp_f<0xB1>(tb_); ta_ += dpp_f<0x4E>(ta_); tb_ += dpp_f<0x4E>(tb_); ta_ += dpp_f<0x141>(ta_); tb_ += dpp_f<0x141>(tb_); \
                if (seg == 0) { ob[(tl_) * 64 + rp] = ta_; ob[(tl_) * 64 + rp + 32] = tb_; } } while (0)
                f32x4 Aw0, Aw1, Akk0, Akk1, Ab0, Ab1, Ak0, Ak1, Ar0, Ar1; float Ava, Avb;
                f32x4 Bw0, Bw1, Bkk0, Bkk1, Bb0, Bb1, Bk0, Bk1, Br0, Br1; float Bva, Bvb;
                RW_LD(A, 0);
#pragma unroll 2
                for (int tl = 0; tl < T; tl += 2) {
                    RW_LD(B, tl + 1);
                    RW_STEP(A, tl);
                    RW_LD(A, tl + 2);
                    RW_STEP(B, tl + 1);
                }
#undef RW_LD
#undef RW_STEP
            } else {
                if (c >= 1) RW_POST(c - 1);
                if (c + 1 < NC) { RW_PREP(c + 1); if (c + 2 < NC) RW_LOAD(c + 2); }
            }
            __syncthreads();
        }
        if (!scanw) RW_POST(NC - 1);
#undef RW_LOAD
#undef RW_PREP
#undef RW_POST
    }
}

__device__ __forceinline__ void phase_hgrn(KP P, int l_, unsigned char* shm) {
    const int l = lsg(l_);
    const int tid = ltid(), wave = tid >> 6, lane = tid & 63, cp = tid >> 4, seg = tid & 15;
    const u16* pC = (const u16*)(P->ws + WS_P);
    u16* OC = (u16*)(P->ws + WS_O);
    constexpr int T = 32;
    float* sF = (float*)shm; float* sQ = sF + T * 128; float* sDV = sQ + T * 128; float* sVN = sDV + T * 64; float* sO = sVN + T * 64; float* sQS = sO + T * 256;
    for (int it = blockIdx.x; it < 256; it += gridDim.x) {
        const int half = it & 1, h = (it >> 1) & 3, b = it >> 3;
        float lb0 = 0.f, lb1 = 0.f;
        if (l == 1) { const float* hl = P->in[26]; lb0 = sigmoidf_(hl[512 + h * 128 + lane] - hl[h * 128 + lane]); lb1 = sigmoidf_(hl[512 + h * 128 + 64 + lane] - hl[h * 128 + 64 + lane]); }
        const float v0a = bf2f(pC[((size_t)b * SEQ) * 2048 + h * 128 + 1024 + half * 64 + cp]), v0b = bf2f(pC[((size_t)b * SEQ) * 2048 + h * 128 + 1024 + half * 64 + cp + 32]);
        f32x2 ea[4], eb[4];
#pragma unroll
        for (int jj = 0; jj < 4; ++jj) { ea[jj] = (f32x2){-v0a, -v0a}; eb[jj] = (f32x2){-v0b, -v0b}; }
        unsigned short gq0[4], gq1[4], gf0[4], gf1[4], gvv[5];
#define HG_LOAD(c0_) do { _Pragma("unroll") for (int i = 0; i < 4; ++i) { const u16* pc_ = pC + ((size_t)b * SEQ + (c0_) + wave * 4 + i) * 2048 + h * 128 + lane; \
            gq0[i] = pc_[0]; gq1[i] = pc_[64]; gf0[i] = pc_[512]; gf1[i] = pc_[512 + 64]; gvv[i] = pc_[1024 + half * 64]; } \
            { const int tn_ = (c0_) + wave * 4 + 4; gvv[4] = tn_ < SEQ ? pC[((size_t)b * SEQ + tn_) * 2048 + h * 128 + lane + 1024 + half * 64] : (unsigned short)0; } } while (0)
#define HG_PREP() do { _Pragma("unroll") for (int i = 0; i < 4; ++i) { const int tl_ = wave * 4 + i; \
            const float q0_ = siluf_(bf2f(gq0[i])), q1_ = siluf_(bf2f(gq1[i])); \
            sQ[tl_ * 128 + lane] = q0_; sQ[tl_ * 128 + 64 + lane] = q1_; \
            sF[tl_ * 128 + lane] = lb0 + (1.f - lb0) * sigmoidf_(bf2f(gf0[i])); sF[tl_ * 128 + 64 + lane] = lb1 + (1.f - lb1) * sigmoidf_(bf2f(gf1[i])); \
            const float vn_ = bf2f(gvv[i + 1]); sDV[tl_ * 64 + lane] = bf2f(gvv[i]) - vn_; sVN[tl_ * 64 + lane] = vn_; \
            const float qs_ = wave_sum(q0_ + q1_); if (lane == 0) sQS[tl_] = qs_; } } while (0)
        HG_LOAD(0); HG_PREP();
        __syncthreads();
        for (int c = 0; c < SEQ / T; ++c) {
            if (c + 1 < SEQ / T) HG_LOAD((c + 1) * T);
#define HG_LD(X, tl_) do { const float* f_ = sF + (tl_) * 128 + seg * 4; const float* q_ = sQ + (tl_) * 128 + seg * 4;   \
                X##f0 = *(const f32x4*)(f_); X##f1 = *(const f32x4*)(f_ + 64); X##q0 = *(const f32x4*)(q_); X##q1 = *(const f32x4*)(q_ + 64); \
                X##va = sDV[(tl_) * 64 + cp]; X##vb = sDV[(tl_) * 64 + 32 + cp]; } while (0)
#define HG_STEP(X, tl_) do { const f32x2 da_ = (f32x2){X##va, X##va}, db_ = (f32x2){X##vb, X##vb}; \
                const f32x2 f0l_ = (f32x2){X##f0[0], X##f0[1]}, f0h_ = (f32x2){X##f0[2], X##f0[3]}, f1l_ = (f32x2){X##f1[0], X##f1[1]}, f1h_ = (f32x2){X##f1[2], X##f1[3]}; \
                const f32x2 q0l_ = (f32x2){X##q0[0], X##q0[1]}, q0h_ = (f32x2){X##q0[2], X##q0[3]}, q1l_ = (f32x2){X##q1[0], X##q1[1]}, q1h_ = (f32x2){X##q1[2], X##q1[3]}; \
                ea[0] = f0l_ * ea[0] + da_; eb[0] = f0l_ * eb[0] + db_; ea[1] = f0h_ * ea[1] + da_; eb[1] = f0h_ * eb[1] + db_; \
                ea[2] = f1l_ * ea[2] + da_; eb[2] = f1l_ * eb[2] + db_; ea[3] = f1h_ * ea[3] + da_; eb[3] = f1h_ * eb[3] + db_; \
                f32x2 oa_ = ea[0] * q0l_ + ea[1] * q0h_; f32x2 ob_ = eb[0] * q0l_ + eb[1] * q0h_; \
                oa_ += ea[2] * q1l_ + ea[3] * q1h_; ob_ += eb[2] * q1l_ + eb[3] * q1h_; \
                float pa_ = oa_[0] + oa_[1], pb_ = ob_[0] + ob_[1]; \
                pa_ += dpp_f<0xB1>(pa_); pb_ += dpp_f<0xB1>(pb_); pa_ += dpp_f<0x4E>(pa_); pb_ += dpp_f<0x4E>(pb_); \
                if ((seg & 3) == 0) { sO[(tl_) * 256 + cp * 4 + (seg >> 2)] = pa_; sO[(tl_) * 256 + (cp + 32) * 4 + (seg >> 2)] = pb_; } } while (0)
            {
                f32x4 Af0, Af1, Aq0, Aq1; float Ava, Avb;
                f32x4 Bf0, Bf1, Bq0, Bq1; float Bva, Bvb;
                HG_LD(A, 0);
#pragma unroll 2
                for (int tl = 0; tl < T; tl += 2) {
                    HG_LD(B, tl + 1);
                    HG_STEP(A, tl);
                    HG_LD(A, tl + 2);
                    HG_STEP(B, tl + 1);
                }
            }
#undef HG_LD
#undef HG_STEP
            __syncthreads();
#pragma unroll
            for (int i = 0; i < 4; ++i) { const int tl = wave * 4 + i; const size_t tok = (size_t)b * SEQ + c * T + tl;
                const f32x4 oa = *(const f32x4*)(sO + tl * 256 + lane * 4);
                const float o = ((oa[0] + oa[1]) + (oa[2] + oa[3])) + sVN[tl * 64 + lane] * sQS[tl];
                OC[tok * 512 + h * 128 + half * 64 + lane] = f2bf(o); }
            if (c + 1 < SEQ / T) HG_PREP();
            __syncthreads();
        }
#undef HG_LOAD
#undef HG_PREP
    }
}
__device__ __forceinline__ void phase_hgrn_post(KP P, int l_) {
    const int l = lsg(l_);
    const int tid_ = ltid(), lane = tid_ & 63, gw = blockIdx.x * 8 + (tid_ >> 6), nw = gridDim.x * 8;
    const u16* pC = (const u16*)(P->ws + WS_P);
    u16* OC = (u16*)(P->ws + WS_O);
    const float* nwp = P->in[27] + (size_t)l * 128 + (lane & 15) * 8;
    float w[8];
#pragma unroll
    for (int j = 0; j < 8; ++j) w[j] = nwp[j];
    for (int rowb = gw; rowb < NTOK; rowb += 4 * nw) {
        uint4 ovs[4], gvs[4];
#pragma unroll
        for (int i = 0; i < 4; ++i) { const int row = rowb + i * nw; if (row < NTOK) { ovs[i] = *(const uint4*)(OC + (size_t)row * 512 + lane * 8); gvs[i] = *(const uint4*)(pC + (size_t)row * 2048 + 1536 + lane * 8); } }
#pragma unroll
        for (int i = 0; i < 4; ++i) { const int row = rowb + i * nw; if (row < NTOK) {
            const uint4 ov = ovs[i], gv = gvs[i];
            float o[8] = {bflo(ov.x), bfhi(ov.x), bflo(ov.y), bfhi(ov.y), bflo(ov.z), bfhi(ov.z), bflo(ov.w), bfhi(ov.w)};
            const float gg[8] = {bflo(gv.x), bfhi(gv.x), bflo(gv.y), bfhi(gv.y), bflo(gv.z), bfhi(gv.z), bflo(gv.w), bfhi(gv.w)};
            float ss = 0.f;
#pragma unroll
            for (int j = 0; j < 8; ++j) ss += o[j] * o[j];
            ss += dpp_f<0xB1>(ss); ss += dpp_f<0x4E>(ss); ss += dpp_f<0x141>(ss); ss += dpp_f<0x140>(ss);
            const float rstd = __builtin_amdgcn_rsqf(ss * (1.f / 128.f) + 1e-6f);
#pragma unroll
            for (int j = 0; j < 8; ++j) o[j] = o[j] * rstd * w[j] * siluf_(gg[j]);
            uint4 st; st.x = cvt_pk_bf16(o[0], o[1]); st.y = cvt_pk_bf16(o[2], o[3]); st.z = cvt_pk_bf16(o[4], o[5]); st.w = cvt_pk_bf16(o[6], o[7]);
            *(uint4*)(OC + (size_t)row * 512 + lane * 8) = st; } }
    }
}

constexpr size_t WS_BAR = WS_MOD + 2816 * 1024;
#define XB_TMO      128
#define XB_XCNT(j)  (256  + 64 * (j))
#define XB_XSUB(j)  (1280 + 64 * (j))
#define XB_XGEN(j)  (2304 + 64 * (j))
#define XB_TOP      3328
#define XB_TOPGEN   3392
#define XCD_BAR_WORDS 3456
#define XB_SPIN_CAP (1u << 22)
__device__ __forceinline__ unsigned xb_ld(unsigned* p)              { return __hip_atomic_load(p, __ATOMIC_RELAXED, __HIP_MEMORY_SCOPE_AGENT); }
__device__ __forceinline__ unsigned xb_add(unsigned* p, unsigned v) { return __hip_atomic_fetch_add(p, v, __ATOMIC_RELAXED, __HIP_MEMORY_SCOPE_AGENT); }
__device__ __forceinline__ unsigned xb_xcc_id() { return (unsigned)__builtin_amdgcn_s_getreg((3 << 11) | 20) & 0xFu; }
#define XB_SPIN(cond, bar) do { unsigned _sp = 0; while (cond) { __builtin_amdgcn_s_sleep(1); \
    if ((++_sp & 255u) == 0u) { if (xb_ld(&(bar)[XB_TMO])) break; if (_sp > XB_SPIN_CAP) { atomicAdd(&(bar)[XB_TMO], 1u); break; } } } } while (0)
struct XcdBarrier { unsigned* bar; unsigned x; volatile LAS unsigned* st; };
__device__ __forceinline__ XcdBarrier xcd_barrier_post(unsigned* bar, volatile LAS unsigned* st) {
    XcdBarrier b; b.bar = bar; b.x = xb_xcc_id(); b.st = st;
    if (threadIdx.x == 0) (void)xb_add(&bar[XB_XCNT(b.x)], 1u);
    return b;
}
__device__ __forceinline__ void xcd_barrier_complete(unsigned* bar, unsigned x, unsigned& nloc, unsigned& nx) {
    const unsigned G = gridDim.x * gridDim.y * gridDim.z;
    unsigned sum, cnt, mine, sp = 0u;
    for (;;) {
        sum = 0u; cnt = 0u; mine = 0u;
#pragma unroll
        for (unsigned j = 0; j < 16; ++j) { const unsigned c = xb_ld(&bar[XB_XCNT(j)]); sum += c; cnt += (c > 0u) ? 1u : 0u; mine = (j == x) ? c : mine; }
        if (sum == G) break;
        __builtin_amdgcn_s_sleep(1);
        if ((++sp & 255u) == 0u) { if (xb_ld(&bar[XB_TMO])) break; if (sp > XB_SPIN_CAP) { atomicAdd(&bar[XB_TMO], 1u); break; } }
    }
    nloc = mine > 0u ? mine : 1u; nx = cnt > 0u ? cnt : 1u;
}
__device__ __forceinline__ void xcd_barrier(const XcdBarrier& b) {
    asm volatile("s_waitcnt vmcnt(0)" ::: "memory");
    __syncthreads();
    if (threadIdx.x == 0) {
        unsigned* bar = b.bar;
        __builtin_amdgcn_s_waitcnt(0);
        unsigned nloc = b.st[0], nx = b.st[1];
        if (nloc == 0u) { xcd_barrier_complete(bar, b.x, nloc, nx); b.st[0] = nloc; b.st[1] = nx; }
        const unsigned old = xb_add(&bar[XB_XSUB(b.x)], 1u);
        const unsigned gen = old / nloc;
        if (old + 1u == (gen + 1u) * nloc) {
            __builtin_amdgcn_fence(__ATOMIC_RELEASE, "agent");
            asm volatile("s_waitcnt vmcnt(0)" ::: "memory");
            const unsigned og = xb_add(&bar[XB_TOP], 1u);
            const unsigned tg = og / nx;
            if (og + 1u == (tg + 1u) * nx) xb_add(&bar[XB_TOPGEN], 1u);
            else XB_SPIN(xb_ld(&bar[XB_TOPGEN]) == tg, bar);
            __builtin_amdgcn_fence(__ATOMIC_ACQUIRE, "agent");
            xb_add(&bar[XB_XGEN(b.x)], 1u);
            asm volatile("s_waitcnt vmcnt(0)" ::: "memory");
        } else {
            XB_SPIN(xb_ld(&bar[XB_XGEN(b.x)]) == gen, bar);
            __builtin_amdgcn_fence(__ATOMIC_ACQUIRE, "agent");
            asm volatile("s_waitcnt vmcnt(0)" ::: "memory");
        }
    }
    __syncthreads();
}
__global__ void __launch_bounds__(512, 2) mega_fwd(Params Parg) {
    extern __shared__ __attribute__((aligned(16))) unsigned char shm[];
    cg::grid_group grid = cg::this_grid();
    LAS unsigned char* lds = (LAS unsigned char*)shm;
    pg8::StaticOrder S;
    if (threadIdx.x < 4) ((volatile LAS unsigned*)(lds + 147456))[threadIdx.x] = 0u;
    __syncthreads();
    (void)xcd_barrier_post((unsigned*)(kparams()->ws + WS_BAR), (volatile LAS unsigned*)(lds + 147456));
    phase_prologue(kparams(), shm);
    grid.sync();
    phase_norm0_sw(kparams(), shm);
    GSYNC();
#pragma nounroll
    for (int l = 0; l < 2; ++l) {
#pragma nounroll
        for (int sub = 0; sub < 3; ++sub) {
            const int j = l * 3 + sub;
            if (sub != 1) {
                const int s = sub >> 1;
                { KP P = kparams(); const u16* Wl = (const u16*)(P->ws + WS_W) + (size_t)l * W_LAYER;
                  pg8::Gemm g; g.A = (const u16*)(P->ws + WS_U); g.Bt = Wl + (s ? W_GU1 : W_GU0); g.M = NTOK; g.N = 5632; g.K = 1024; EpiGU e; e.hid = (u16*)(P->ws + WS_Z);
                  e.ss = (const float*)(P->ws + WS_SS) + (size_t)j * NTOK; e.sw = (const float*)(P->ws + WS_SW) + (size_t)l * SW_LAYER + (s ? SW_GU1 : SW_GU0);
                  S.init(g.M, g.N, gridDim.x, blockIdx.x); pg8::gemm_phase<EpiGU>(lds, g, S, e); }
                GSYNC();
            } else {
#pragma nounroll
                for (int br = 0; br < 3; ++br) {
                    { KP P = kparams(); const u16* Wl = (const u16*)(P->ws + WS_W) + (size_t)l * W_LAYER;
                      pg8::Gemm g; g.A = (const u16*)(P->ws + WS_U); g.Bt = Wl + (br == 0 ? W_INA : (br == 1 ? W_INB : W_INC)); g.M = NTOK; g.N = br == 0 ? 1536 : 2048; g.K = 1024;
                      EpiBf16 e; e.O = (u16*)(P->ws + WS_P); e.ldc = g.N;
                      e.ss = (const float*)(P->ws + WS_SS) + (size_t)j * NTOK; e.sw = (const float*)(P->ws + WS_SW) + (size_t)l * SW_LAYER + (br == 0 ? SW_INA : (br == 1 ? SW_INB : SW_INC));
                      S.init(g.M, g.N, gridDim.x, blockIdx.x); pg8::gemm_phase<EpiBf16>(lds, g, S, e); }
                    GSYNC();
                    if (br == 0) {
                        phase_attn_prep(kparams(), l, shm); GSYNC();
                        phase_attn(kparams(), l, shm); GSYNC();
                    } else if (br == 1) {
                        phase_lora_prep(kparams(), l); GSYNC();
                        { KP P = kparams(); const u16* Wl = (const u16*)(P->ws + WS_W) + (size_t)l * W_LAYER;
                          pg8::Gemm g; g.A = (const u16*)(P->ws + WS_O); g.Bt = Wl + W_LORA; g.M = NTOK; g.N = 1536; g.K = 384;
                          EpiBf16 e; e.O = (u16*)(P->ws + WS_LO); e.ldc = 1536; e.ss = nullptr; e.sw = nullptr;
                          S.init(g.M, g.N, gridDim.x, blockIdx.x); pg8::gemm_phase<EpiBf16>(lds, g, S, e); }
                        GSYNC();
                        phase_rwkv(kparams(), l, shm); GSYNC();
                    } else {
                        phase_hgrn(kparams(), l, shm); GSYNC();
                        phase_hgrn_post(kparams(), l); GSYNC();
                    }
                    { KP P = kparams(); const u16* Wl = (const u16*)(P->ws + WS_W) + (size_t)l * W_LAYER;
                      pg8::Gemm g; g.A = (const u16*)(P->ws + WS_O); g.Bt = Wl + (br == 0 ? W_OA : (br == 1 ? W_OB : W_OC)); g.M = NTOK; g.N = 1024; g.K = 512;
                      EpiBf16 e; e.O = (u16*)(P->ws + WS_P); e.ldc = 1024; e.ss = nullptr; e.sw = nullptr;
                      S.init(g.M, g.N, gridDim.x, blockIdx.x); pg8::gemm_phase<EpiBf16>(lds, g, S, e); }
                    GSYNC();
                    { KP P = kparams(); const u16* Wl = (const u16*)(P->ws + WS_W) + (size_t)l * W_LAYER;
                      pg8::Gemm g; g.A = (const u16*)(P->ws + WS_U); g.Bt = Wl + W_G + (size_t)br * 1024 * 1024; g.M = NTOK; g.N = 1024; g.K = 1024;
                      EpiGate e; e.Z = (u16*)(P->ws + WS_Z); e.Y = (const u16*)(P->ws + WS_P); e.first = (br == 0);
                      e.ss = (const float*)(P->ws + WS_SS) + (size_t)j * NTOK; e.sw = (const float*)(P->ws + WS_SW) + (size_t)l * SW_LAYER + SW_G + (size_t)br * 1024;
                      S.init(g.M, g.N, gridDim.x, blockIdx.x); pg8::gemm_phase<EpiGate>(lds, g, S, e); }
                    GSYNC();
                }
            }
            { KP P = kparams(); const u16* Wl = (const u16*)(P->ws + WS_W) + (size_t)l * W_LAYER;
              const float* modall = (const float*)(P->ws + WS_MOD);
              const float* modl = modall + (size_t)l * 32 * 9216;
              const bool ffn = (sub != 1); const int jn = j + 1, ln = jn / 3, subn = jn % 3; const bool has_next = jn < 6;
              pg8::Gemm g; g.M = NTOK; g.N = 1024; g.A = (const u16*)(P->ws + WS_Z); g.Bt = Wl + (ffn ? ((sub >> 1) ? W_D1 : W_D0) : W_OUT); g.K = ffn ? DFF : 1024;
              const float* hin_ = (j == 0) ? P->in[0] : (const float*)P->out;
              const float* mv_ = modl + (ffn ? (3 * sub + 2) : 5) * 1024;
              u16* hb_ = (u16*)(P->ws + WS_U);
              float* ssn_ = (float*)(P->ws + WS_SS) + (size_t)(has_next ? jn : 0) * NTOK;
              const float* nwn_ = P->in[5] + (size_t)(has_next ? (ln * 3 + subn) : 0) * 1024;
              const float* scn_ = modall + (size_t)(has_next ? ln : 0) * 32 * 9216 + (3 * (has_next ? subn : 0) + 1) * 1024;
              const EpiRes e = {hin_, P->out, mv_, ffn ? 1 : 0, hb_, ssn_, nwn_, scn_, has_next ? 1 : 0};
              S.init(g.M, g.N, gridDim.x, blockIdx.x); pg8::gemm_phase<EpiRes>(lds, g, S, e); }
            if (j < 5) GSYNC();
        }
    }
}

extern "C" void kernel_launch(void* const* d_in, const int* in_sizes, int n_in, void* d_out, int out_size, void* d_ws, size_t ws_size, hipStream_t stream) {
    static int grid_blocks = 0;
    if (!grid_blocks) {
        int dev = 0, cus = 0, per_cu = 0;
        hipGetDevice(&dev);
        hipDeviceGetAttribute(&cus, hipDeviceAttributeMultiprocessorCount, dev);
        hipFuncSetAttribute((const void*)mega_fwd, hipFuncAttributeMaxDynamicSharedMemorySize, LDS_BYTES);
        hipOccupancyMaxActiveBlocksPerMultiprocessor(&per_cu, (const void*)mega_fwd, 512, LDS_BYTES);
        if (per_cu < 1) per_cu = 1;
        grid_blocks = cus * per_cu;
        if (n_in != 30 || ws_size < 899 * MiB) fprintf(stderr, "kernel_launch: unexpected n_in %d or ws_size %zu (< %zu)\n", n_in, ws_size, (size_t)(899 * MiB));
    }
    Params p{};
    for (int i = 0; i < 30; ++i) p.in[i] = (const float*)d_in[i];
    p.out = (float*)d_out; p.ws = (unsigned char*)d_ws;
    hipMemsetAsync((unsigned char*)d_ws + WS_BAR, 0, XCD_BAR_WORDS * 4, stream);
    void* args[] = {&p};
    hipError_t e = hipLaunchCooperativeKernel((const void*)mega_fwd, dim3(grid_blocks), dim3(512), args, LDS_BYTES, stream);
    if (e != hipSuccess) fprintf(stderr, "cooperative launch failed: %s (grid %d)\n", hipGetErrorString(e), grid_blocks);
}
```

```cpp
#include <hip/hip_runtime.h>
#include <hip/hip_cooperative_groups.h>
#include <cstdio>
namespace cg = cooperative_groups;

typedef unsigned short u16;
typedef short bf16x8 __attribute__((ext_vector_type(8)));
typedef float f32x4 __attribute__((ext_vector_type(4)));
typedef float f32x2 __attribute__((ext_vector_type(2)));
#define LAS __attribute__((address_space(3)))

constexpr int DM = 1024, NB = 32, SEQ = 2048, NTOK = NB * SEQ, DFF = 2816, PTOT = 8480;
constexpr int LDS_BYTES = 147456 + 16;
#define REP_ATTN 1
#define REP_RWKV 1
#define REP_HGRN 1
#define REP_GEMM 1
#define REP_SYNC 1
#define GSYNC() do { for (int r_ = 0; r_ < REP_SYNC; ++r_) { XcdBarrier xb_; xb_.bar = (unsigned*)(kparams()->ws + WS_BAR); xb_.x = xb_xcc_id(); xb_.st = (volatile LAS unsigned*)(lds + 147456); xcd_barrier(xb_); } } while (0)

constexpr size_t MiB = 1u << 20;
constexpr size_t W_GU0 = 0, W_GU1 = W_GU0 + 5632ull * 1024, W_D0 = W_GU1 + 5632ull * 1024, W_D1 = W_D0 + 1024ull * 2816,
                 W_INA = W_D1 + 1024ull * 2816, W_INB = W_INA + 1536ull * 1024, W_INC = W_INB + 2048ull * 1024, W_G = W_INC + 2048ull * 1024,
                 W_OA = W_G + 3072ull * 1024, W_OB = W_OA + 1024ull * 512, W_OC = W_OB + 1024ull * 512, W_OUT = W_OC + 1024ull * 512,
                 W_LORA = W_OUT + 1024ull * 1024, W_LAYER = W_LORA + 1536ull * 384;
constexpr size_t WS_W = 0, WS_MOD = 120 * MiB, WS_U = 123 * MiB, WS_Z = 251 * MiB, WS_P = 379 * MiB, WS_O = 635 * MiB, WS_LO = 699 * MiB, WS_END = 891 * MiB;
static_assert(W_LAYER * 2 * 2 <= 120 * MiB, "weights fit");
constexpr size_t WS_SS = 891 * MiB, WS_SW = 893 * MiB;
constexpr size_t SW_GU0 = 0, SW_GU1 = 32ull * 5632, SW_INA = 2 * 32ull * 5632, SW_INB = SW_INA + 32ull * 1536, SW_INC = SW_INB + 32ull * 2048, SW_G = SW_INC + 32ull * 2048, SW_LAYER = SW_G + 32ull * 3072;

struct Params { const float* in[30]; float* out; unsigned char* ws; };
typedef const Params __attribute__((address_space(4)))* KP;
__device__ __forceinline__ KP kparams() { KP p = (KP)__builtin_amdgcn_kernarg_segment_ptr(); asm volatile("" : "+s"(p)); return p; }
__device__ __forceinline__ int ltid() { int t = threadIdx.x; asm volatile("" : "+v"(t)); return t; }
__device__ __forceinline__ int lsg(int x) { x = __builtin_amdgcn_readfirstlane(x); asm volatile("" : "+s"(x)); return x; }
__device__ __forceinline__ float shfl_xor_l(float v, int m, int lane) { return __int_as_float(__builtin_amdgcn_ds_bpermute((lane ^ m) << 2, __float_as_int(v))); }
__device__ __forceinline__ bf16x8 as_bf16x8(uint4 v) { return __builtin_bit_cast(bf16x8, v); }

__device__ __forceinline__ unsigned cvt_pk_bf16(float lo, float hi) { unsigned r; asm volatile("s_nop 0\n\tv_cvt_pk_bf16_f32 %0, %1, %2" : "=v"(r) : "v"(lo), "v"(hi)); return r; }
__device__ __forceinline__ float bf2f(u16 h) { return __uint_as_float((unsigned)h << 16); }
__device__ __forceinline__ float bflo(unsigned w) { return __uint_as_float(w << 16); }
__device__ __forceinline__ float bfhi(unsigned w) { return __uint_as_float(w & 0xffff0000u); }
__device__ __forceinline__ u16 f2bf(float f) { return (u16)(cvt_pk_bf16(f, 0.f) & 0xffffu); }
__device__ __forceinline__ float sigmoidf_(float x) { return __builtin_amdgcn_rcpf(1.f + __expf(-x)); }
__device__ __forceinline__ float sigmoid_fast(float x) { return __builtin_amdgcn_rcpf(1.f + __expf(-x)); }
__device__ __forceinline__ float siluf_(float x) { return x * __builtin_amdgcn_rcpf(1.f + __expf(-x)); }
__device__ __forceinline__ float tanhf_(float x) { return 1.f - 2.f * __builtin_amdgcn_rcpf(__expf(2.f * x) + 1.f); }
template <int CTRL> __device__ __forceinline__ float dpp_f(float x) { return __int_as_float(__builtin_amdgcn_update_dpp(0, __float_as_int(x), CTRL, 0xF, 0xF, true)); }
__device__ __forceinline__ float wave_sum(float v) {
    v += dpp_f<0xB1>(v); v += dpp_f<0x4E>(v); v += dpp_f<0x141>(v); v += dpp_f<0x140>(v);
    v += __int_as_float(__builtin_amdgcn_update_dpp(0, __float_as_int(v), 0x142, 0xA, 0xF, false));
    v += __int_as_float(__builtin_amdgcn_update_dpp(0, __float_as_int(v), 0x143, 0xC, 0xF, false));
    return __int_as_float(__builtin_amdgcn_readlane(__float_as_int(v), 63));
}
__device__ __forceinline__ float sum8(float v) { v += dpp_f<0xB1>(v); v += dpp_f<0x4E>(v); v += dpp_f<0x141>(v); return v; }

namespace pg8 {
constexpr int BM = 256, BK = 64, HALF = 128, HTB = HALF * BK * 2, STAGE_BYTES = 8 * HTB, NXCD = 8, WGM = 4;
__host__ __device__ __forceinline__ int lds_byte(int r, int c) { const int st = (r >> 4) * 2 + (c >> 5), rr = r & 15, cc = c & 31, ob = rr * 64 + cc * 2; return st * 1024 + (ob ^ (((ob >> 9) & 1) << 5)); }
__host__ __device__ __forceinline__ void stage_rc(int b, int& R, int& C) { const int st = b / 1024, sb = b % 1024, swz = sb ^ (((sb >> 9) & 1) << 5); R = (st >> 1) * 16 + swz / 64; C = (st & 1) * 32 + (swz % 64) / 2; }
__host__ __device__ __forceinline__ int perm32(int rho) { const int n = rho >> 4, i = rho & 15; return 8 * (i >> 2) + 4 * n + (i & 3); }
struct Unit { int pm, pn; };
struct Gemm { const u16* A; const u16* Bt; int M, N, K; };
struct StaticOrder {
    int nM, nN, nwg, G, c;
    __device__ void init(int M, int N, int G_, int c_) { nM = M / BM; nN = N / BM; nwg = nM * nN; G = G_; c = c_; }
    __device__ bool next(int i, Unit& u) const {
        const long L = (long)i * G + c; if (L >= nwg) return false;
        int wgid = (int)L; { const int q = nwg / NXCD, r = nwg % NXCD, xcd = wgid % NXCD, off = wgid / NXCD; wgid = (xcd < r ? xcd * (q + 1) : r * (q + 1) + (xcd - r) * q) + off; }
        const int wgm = (nN <= 4) ? 8 : WGM;
        const int nig = wgm * nN, gid = wgid / nig, fm = gid * wgm, gsz = (nM - fm) < wgm ? (nM - fm) : wgm;
        u.pm = fm + ((wgid % nig) % gsz); u.pn = (wgid % nig) / gsz; return true;
    }
};
template <class Epi>
__device__ __forceinline__ void gemm_phase(LAS unsigned char* lds, const Gemm g, const StaticOrder& S, const Epi& E) {
    const int tid = ltid(), wid = __builtin_amdgcn_readfirstlane(tid >> 6), lane = tid & 63, wr = wid >> 2, wc = wid & 3, fr = lane & 15, fq = lane >> 4;
    const int K = g.K, nt = K / BK;
    unsigned voffA[2], voffB[2];
#pragma unroll
    for (int i = 0; i < 2; ++i) { int R, C; stage_rc(tid * 16 + i * 8192, R, C); const int Rb = Epi::PERM ? ((R & ~31) + perm32(R & 31)) : R;
        voffA[i] = (unsigned)(R * K + C) * 2u; voffB[i] = (unsigned)(Rb * K + C) * 2u; }
    const size_t kstep = (size_t)(BK * 2);
    const size_t hstep = (size_t)HALF * K * 2;
    const size_t tstep = 2 * hstep;
    const unsigned ldsw = (unsigned)wid * 1024u;
    const int aoff = lds_byte(wr * 64 + fr, fq * 8), boff = lds_byte(wc * 32 + fr, fq * 8);
#define PG8_SA(b, h) (((b) * 2 + (h)) * HTB)
#define PG8_SB(b, h) ((4 + (b) * 2 + (h)) * HTB)
#define PG8_STAGE(bufoff, gbase, voff) do { _Pragma("unroll") for (int _i = 0; _i < 2; ++_i) \
        __builtin_amdgcn_global_load_lds((const unsigned*)((const char*)(gbase) + (voff)[_i]), (LAS unsigned*)(lds + (bufoff) + ldsw + _i * 8192), 16, 0, 0); } while (0)
#define PG8_LDA(dst, b, h) do { _Pragma("unroll") for (int m = 0; m < 4; ++m) _Pragma("unroll") for (int k = 0; k < 2; ++k) dst[m][k] = *(const LAS bf16x8*)(lds + PG8_SA(b, h) + aoff + m * 2048 + k * 1024); } while (0)
#define PG8_LDB(dst, b, h) do { _Pragma("unroll") for (int n = 0; n < 2; ++n) _Pragma("unroll") for (int k = 0; k < 2; ++k) dst[n][k] = *(const LAS bf16x8*)(lds + PG8_SB(b, h) + boff + n * 2048 + k * 1024); } while (0)
#define PG8_MMA(ai, bj, At, Bt) do { __builtin_amdgcn_s_setprio(1); _Pragma("unroll") for (int m = 0; m < 4; ++m) _Pragma("unroll") for (int n = 0; n < 2; ++n) _Pragma("unroll") for (int k = 0; k < 2; ++k) \
        acc[ai][bj][m][n] = __builtin_amdgcn_mfma_f32_16x16x32_bf16(Bt[n][k], At[m][k], acc[ai][bj][m][n], 0, 0, 0); __builtin_amdgcn_s_setprio(0); } while (0)
#define PG8_WAIT_V(n) asm volatile("s_waitcnt vmcnt(" #n ")" ::: "memory")
#define PG8_WAIT_L(n) asm volatile("s_waitcnt lgkmcnt(" #n ")" ::: "memory")
#define PG8_BAR __builtin_amdgcn_s_barrier()
#define PG8_SCHED __builtin_amdgcn_sched_barrier(0)
    Unit cur, nxt; int ui = 0;
    if (!S.next(0, cur)) return;
    f32x4 acc[2][2][4][2];
#pragma unroll
    for (int a = 0; a < 2; ++a)
#pragma unroll
        for (int b = 0; b < 2; ++b)
#pragma unroll
            for (int m = 0; m < 4; ++m)
#pragma unroll
                for (int n = 0; n < 2; ++n) acc[a][b][m][n] = (f32x4){0.f, 0.f, 0.f, 0.f};
    bf16x8 At[4][2], B0[2][2], B1[2][2];
    const char* cA = (const char*)g.A + (size_t)cur.pm * tstep; const char* cB = (const char*)g.Bt + (size_t)cur.pn * tstep;
    PG8_STAGE(PG8_SB(0, 0), cB, voffB); PG8_STAGE(PG8_SA(0, 0), cA, voffA); PG8_STAGE(PG8_SB(0, 1), cB + hstep, voffB); PG8_STAGE(PG8_SA(0, 1), cA + hstep, voffA);
    if (wr == 1) PG8_BAR;
    PG8_WAIT_V(4); PG8_BAR;
    PG8_STAGE(PG8_SB(1, 0), cB + kstep, voffB); PG8_STAGE(PG8_SA(1, 0), cA + kstep, voffA); PG8_STAGE(PG8_SB(1, 1), cB + hstep + kstep, voffB);
    PG8_WAIT_V(6); PG8_BAR;
    for (;;) {
        const bool has_next = S.next(ui + 1, nxt);
        const char* nA = has_next ? (const char*)g.A + (size_t)nxt.pm * tstep : cA; const char* nB = has_next ? (const char*)g.Bt + (size_t)nxt.pn * tstep : cB;
        for (int t = 0; t < nt; t += 2) {
            const bool last = (t == nt - 2);
            const char* a1 = cA + (size_t)(t + 1) * kstep;
            const char* a2 = last ? nA : cA + (size_t)(t + 2) * kstep; const char* b2 = last ? nB : cB + (size_t)(t + 2) * kstep;
            const char* a3 = a2 + kstep; const char* b3 = b2 + kstep;
            PG8_LDB(B0, 0, 0); PG8_SCHED; PG8_LDA(At, 0, 0); PG8_STAGE(PG8_SA(1, 1), a1 + hstep, voffA);
            PG8_WAIT_L(8); PG8_BAR; PG8_WAIT_L(0); PG8_MMA(0, 0, At, B0); PG8_BAR; PG8_SCHED;
            PG8_LDB(B1, 0, 1); PG8_STAGE(PG8_SB(0, 0), b2, voffB);
            PG8_BAR; PG8_WAIT_L(0); PG8_MMA(0, 1, At, B1); PG8_BAR;
            PG8_LDA(At, 0, 1); PG8_STAGE(PG8_SA(0, 0), a2, voffA);
            PG8_BAR; PG8_WAIT_L(0); PG8_MMA(1, 0, At, B0); PG8_BAR; PG8_SCHED;
            PG8_STAGE(PG8_SB(0, 1), b2 + hstep, voffB);
            PG8_WAIT_V(6); PG8_BAR; PG8_MMA(1, 1, At, B1); PG8_BAR;
            PG8_LDB(B0, 1, 0); PG8_SCHED; PG8_LDA(At, 1, 0); PG8_STAGE(PG8_SA(0, 1), a2 + hstep, voffA);
            PG8_WAIT_L(8); PG8_BAR; PG8_WAIT_L(0); PG8_MMA(0, 0, At, B0); PG8_BAR; PG8_SCHED;
            PG8_LDB(B1, 1, 1); PG8_STAGE(PG8_SB(1, 0), b3, voffB);
            PG8_BAR; PG8_WAIT_L(0); PG8_MMA(0, 1, At, B1); PG8_BAR;
            PG8_LDA(At, 1, 1); PG8_STAGE(PG8_SA(1, 0), a3, voffA);
            PG8_BAR; PG8_WAIT_L(0); PG8_MMA(1, 0, At, B0); PG8_BAR; PG8_SCHED;
            PG8_STAGE(PG8_SB(1, 1), b3 + hstep, voffB);
            PG8_WAIT_V(6); PG8_BAR; PG8_MMA(1, 1, At, B1); PG8_BAR;
        }
        E(acc, cur, wr, wc, fr, fq);
        if (!has_next) break;
#pragma unroll
        for (int a = 0; a < 2; ++a)
#pragma unroll
            for (int b = 0; b < 2; ++b)
#pragma unroll
                for (int m = 0; m < 4; ++m)
#pragma unroll
                    for (int n = 0; n < 2; ++n) acc[a][b][m][n] = (f32x4){0.f, 0.f, 0.f, 0.f};
        cur = nxt; cA = nA; cB = nB; ++ui;
    }
    PG8_WAIT_V(0);
    if (wr == 0) PG8_BAR;
    PG8_BAR;
#undef PG8_SA
#undef PG8_SB
#undef PG8_STAGE
#undef PG8_LDA
#undef PG8_LDB
#undef PG8_MMA
#undef PG8_WAIT_V
#undef PG8_WAIT_L
#undef PG8_BAR
#undef PG8_SCHED
}
}
using pg8::Unit;

__device__ __forceinline__ void load_rstd(const float* ss, int row0, f32x4& ra, f32x4& rb) {
    float t[8];
#pragma unroll
    for (int i = 0; i < 8; ++i) t[i] = ss[row0 + (i >> 2) * 128 + (i & 3) * 16];
#pragma unroll
    for (int i = 0; i < 4; ++i) { ra[i] = __builtin_amdgcn_rsqf(t[i] * (1.f / 1024.f) + 1e-6f); rb[i] = __builtin_amdgcn_rsqf(t[4 + i] * (1.f / 1024.f) + 1e-6f); }
}
struct EpiGU {
    static constexpr bool PERM = true;
    u16* hid; const float* ss; const float* sw;
    __device__ __forceinline__ void operator()(const f32x4 (&acc)[2][2][4][2], const Unit& u, int wr, int wc, int fr, int fq) const {
        const int row0 = u.pm * 256 + wr * 64 + fr, hc0 = u.pn * 128 + wc * 32 + fq * 8;
        const float* swp = sw + (size_t)(u.pm >> 3) * 5632 + u.pn * 256 + wc * 32 + 8 * fq;
        f32x4 ra, rb; load_rstd(ss, row0, ra, rb);
        const f32x4 sg0 = *(const f32x4*)(swp), sg1 = *(const f32x4*)(swp + 4), su0 = *(const f32x4*)(swp + 128), su1 = *(const f32x4*)(swp + 132);
#pragma unroll
        for (int ai = 0; ai < 2; ++ai)
#pragma unroll
            for (int m = 0; m < 4; ++m) { const int r = row0 + ai * 128 + m * 16;
                const float rstd = ai ? rb[m] : ra[m];
                const f32x4 g0 = acc[ai][0][m][0] * rstd + sg0, g1 = acc[ai][0][m][1] * rstd + sg1, u0 = acc[ai][1][m][0] * rstd + su0, u1 = acc[ai][1][m][1] * rstd + su1;
                uint4 st; st.x = cvt_pk_bf16(siluf_(g0[0]) * u0[0], siluf_(g0[1]) * u0[1]); st.y = cvt_pk_bf16(siluf_(g0[2]) * u0[2], siluf_(g0[3]) * u0[3]);
                st.z = cvt_pk_bf16(siluf_(g1[0]) * u1[0], siluf_(g1[1]) * u1[1]); st.w = cvt_pk_bf16(siluf_(g1[2]) * u1[2], siluf_(g1[3]) * u1[3]);
                *(uint4*)(hid + (size_t)r * DFF + hc0) = st; }
    }
};
struct EpiRes {
    static constexpr bool PERM = false;
    const float* hin; float* hout; const float* mv; int ffn;
    u16* hbp; float* ssn; const float* nwn; const float* scn; int has_next;
    __device__ __forceinline__ void operator()(const f32x4 (&acc)[2][2][4][2], const Unit& u, int wr, int wc, int fr, int fq) const {
        const int row0 = u.pm * 256 + wr * 64 + fr, col0 = u.pn * 256 + wc * 32 + 4 * fq;
        const float* mvp = mv + (size_t)(u.pm >> 3) * 9216 + col0;
        const float fac = __builtin_amdgcn_readfirstlane(ffn) ? 0.5f : 1.f;
        const bool hb = __builtin_amdgcn_readfirstlane(has_next) != 0;
        f32x4 rs0 = (f32x4){0.f, 0.f, 0.f, 0.f}, rs1 = rs0;
#pragma unroll
        for (int bj = 0; bj < 2; ++bj)
#pragma unroll
            for (int n = 0; n < 2; ++n) {
                const int co = bj * 128 + n * 16;
                const f32x4 mvv = *(const f32x4*)(mvp + co) * fac;
                f32x4 gn = (f32x4){0.f, 0.f, 0.f, 0.f};
                if (hb) gn = *(const f32x4*)(nwn + col0 + co) * (*(const f32x4*)(scn + (size_t)(u.pm >> 3) * 9216 + col0 + co) + 1.f);
                f32x4 hld[8];
#pragma unroll
                for (int i = 0; i < 8; ++i) hld[i] = *(const f32x4*)(hin + (size_t)(row0 + (i >> 2) * 128 + (i & 3) * 16) * DM + col0 + co);
#pragma unroll
                for (int ai = 0; ai < 2; ++ai)
#pragma unroll
                    for (int m = 0; m < 4; ++m) { const size_t off = (size_t)(row0 + ai * 128 + m * 16) * DM + col0 + co;
                        const f32x4 hv = hld[ai * 4 + m] + mvv * acc[ai][bj][m][n];
                        *(f32x4*)(hout + off) = hv;
                        if (hb) { const float q_ = hv[0] * hv[0] + hv[1] * hv[1] + hv[2] * hv[2] + hv[3] * hv[3]; if (ai == 0) rs0[m] += q_; else rs1[m] += q_;
                            const f32x4 y = hv * gn; uint2 st; st.x = cvt_pk_bf16(y[0], y[1]); st.y = cvt_pk_bf16(y[2], y[3]);
                            *(uint2*)(hbp + off) = st; } }
            }
        if (hb) {
            const int lane = fq * 16 + fr;
#pragma unroll
            for (int i = 0; i < 8; ++i) { float v = (i < 4) ? rs0[i & 3] : rs1[i & 3]; v += shfl_xor_l(v, 16, lane); v += shfl_xor_l(v, 32, lane);
                if (fq == 0) atomicAdd(ssn + row0 + (i >> 2) * 128 + (i & 3) * 16, v); }
        }
    }
};
struct EpiBf16 {
    static constexpr bool PERM = true;
    u16* O; int ldc; const float* ss; const float* sw;
    __device__ __forceinline__ void operator()(const f32x4 (&acc)[2][2][4][2], const Unit& u, int wr, int wc, int fr, int fq) const {
        const int row0 = u.pm * 256 + wr * 64 + fr, col0 = u.pn * 256 + wc * 32 + 8 * fq;
        f32x4 ra = (f32x4){1.f, 1.f, 1.f, 1.f}, rb = ra;
        f32x4 swv[4] = {(f32x4){0.f, 0.f, 0.f, 0.f}, (f32x4){0.f, 0.f, 0.f, 0.f}, (f32x4){0.f, 0.f, 0.f, 0.f}, (f32x4){0.f, 0.f, 0.f, 0.f}};
        if (ss) { load_rstd(ss, row0, ra, rb); const float* swp = sw + (size_t)(u.pm >> 3) * ldc + col0;
            swv[0] = *(const f32x4*)(swp); swv[1] = *(const f32x4*)(swp + 4); swv[2] = *(const f32x4*)(swp + 128); swv[3] = *(const f32x4*)(swp + 132); }
#pragma unroll
        for (int bj = 0; bj < 2; ++bj) {
            const f32x4 s0 = swv[2 * bj], s1 = swv[2 * bj + 1];
#pragma unroll
            for (int ai = 0; ai < 2; ++ai)
#pragma unroll
                for (int m = 0; m < 4; ++m) { const int r = row0 + ai * 128 + m * 16;
                    const float rstd = ai ? rb[m] : ra[m];
                    const f32x4 v0 = acc[ai][bj][m][0] * rstd + s0, v1 = acc[ai][bj][m][1] * rstd + s1;
                    uint4 st; st.x = cvt_pk_bf16(v0[0], v0[1]); st.y = cvt_pk_bf16(v0[2], v0[3]); st.z = cvt_pk_bf16(v1[0], v1[1]); st.w = cvt_pk_bf16(v1[2], v1[3]);
                    *(uint4*)(O + (size_t)r * ldc + col0 + bj * 128) = st; }
        }
    }
};
struct EpiGate {
    static constexpr bool PERM = true;
    u16* Z; const u16* Y; int first; const float* ss; const float* sw;
    __device__ __forceinline__ void operator()(const f32x4 (&acc)[2][2][4][2], const Unit& u, int wr, int wc, int fr, int fq) const {
        const int row0 = u.pm * 256 + wr * 64 + fr, col0 = u.pn * 256 + wc * 32 + 8 * fq;
        f32x4 ra, rb; load_rstd(ss, row0, ra, rb);
        const float* swp = sw + (size_t)(u.pm >> 3) * 3072 + col0;
        const f32x4 swv[4] = {*(const f32x4*)(swp), *(const f32x4*)(swp + 4), *(const f32x4*)(swp + 128), *(const f32x4*)(swp + 132)};
#pragma unroll
        for (int bj = 0; bj < 2; ++bj) {
            const f32x4 s0 = swv[2 * bj], s1 = swv[2 * bj + 1];
#pragma unroll
            for (int ai = 0; ai < 2; ++ai) {
                uint4 yld[4], zld[4];
#pragma unroll
                for (int i = 0; i < 4; ++i) { const size_t off = (size_t)(row0 + ai * 128 + i * 16) * DM + col0 + bj * 128;
                    yld[i] = *(const uint4*)(Y + off); zld[i] = first ? make_uint4(0u, 0u, 0u, 0u) : *(const uint4*)(Z + off); }
#pragma unroll
                for (int m = 0; m < 4; ++m) { const int rr = row0 + ai * 128 + m * 16; const size_t off = (size_t)rr * DM + col0 + bj * 128;
                    const float rstd = ai ? rb[m] : ra[m];
                    const f32x4 v0 = acc[ai][bj][m][0] * rstd + s0, v1 = acc[ai][bj][m][1] * rstd + s1;
                    const uint4 yv = yld[m], zv = zld[m];
                    float r[8];
                    r[0] = sigmoid_fast(v0[0]) * bflo(yv.x); r[1] = sigmoid_fast(v0[1]) * bfhi(yv.x); r[2] = sigmoid_fast(v0[2]) * bflo(yv.y); r[3] = sigmoid_fast(v0[3]) * bfhi(yv.y);
                    r[4] = sigmoid_fast(v1[0]) * bflo(yv.z); r[5] = sigmoid_fast(v1[1]) * bfhi(yv.z); r[6] = sigmoid_fast(v1[2]) * bflo(yv.w); r[7] = sigmoid_fast(v1[3]) * bfhi(yv.w);
                    r[0] += bflo(zv.x); r[1] += bfhi(zv.x); r[2] += bflo(zv.y); r[3] += bfhi(zv.y); r[4] += bflo(zv.z); r[5] += bfhi(zv.z); r[6] += bflo(zv.w); r[7] += bfhi(zv.w);
                    uint4 st; st.x = cvt_pk_bf16(r[0], r[1]); st.y = cvt_pk_bf16(r[2], r[3]); st.z = cvt_pk_bf16(r[4], r[5]); st.w = cvt_pk_bf16(r[6], r[7]);
                    *(uint4*)(Z + off) = st; }
            }
        }
    }
};

__device__ __forceinline__ float w_fetch(KP P, int l, int mat, int n, int k) {
    switch (mat) {
    case 0: case 1: { const int hc = 128 * (n >> 8) + (n & 127); const float* src = (n & 128) ? P->in[7] : P->in[6]; return src[((size_t)(l * 2 + mat) * 1024 + k) * DFF + hc]; }
    case 2: case 3: return P->in[8][((size_t)(l * 2 + (mat - 2)) * DFF + k) * 1024 + n];
    case 4: return P->in[9][((size_t)l * 1024 + k) * PTOT + n];
    case 5: return n < 1824 ? P->in[9][((size_t)l * 1024 + k) * PTOT + 1536 + n] : 0.f;
    case 6: return P->in[9][((size_t)l * 1024 + k) * PTOT + 3360 + n];
    case 7: return P->in[9][((size_t)l * 1024 + k) * PTOT + 5408 + n];
    case 8: return P->in[13][((size_t)l * 512 + k) * 1024 + n];
    case 9: return P->in[25][((size_t)l * 512 + k) * 1024 + n];
    case 10: return P->in[28][((size_t)l * 512 + k) * 1024 + n];
    case 11: return P->in[29][((size_t)l * 1024 + k) * 1024 + n];
    default: {
        if (n < 512) return k < 64 ? P->in[16][((size_t)l * 64 + k) * 512 + n] : 0.f;
        if (n < 1024) return (k >= 64 && k < 128) ? P->in[18][((size_t)l * 64 + (k - 64)) * 512 + (n - 512)] : 0.f;
        return (k >= 128 && k < 288) ? P->in[19][((size_t)l * 160 + (k - 128)) * 512 + (n - 1024)] : 0.f; }
    }
}
__device__ const int kNT[13] = {88, 88, 16, 16, 24, 32, 32, 48, 16, 16, 16, 16, 24};
__device__ const int kKT[13] = {8, 8, 22, 22, 8, 8, 8, 8, 4, 4, 4, 8, 3};
__device__ const unsigned long long kDO[13] = {W_GU0, W_GU1, W_D0, W_D1, W_INA, W_INB, W_INC, W_G, W_OA, W_OB, W_OC, W_OUT, W_LORA};
__device__ __forceinline__ void phase_prologue(KP P, unsigned char* shm) {
    const int tid = ltid();
    float* tile = (float*)shm;
    u16* Wall = (u16*)(P->ws + WS_W);
    constexpr int TPL = 3592;
    {
        const int nn = tid & 63, kq = tid >> 6;
        int l = 0, mat = 0, n0 = 0, k0 = 0, K = 0; size_t dofs = 0;
        float v[16];
#define PRO_DEC(t_) do { l = (t_) / TPL; int r_ = (t_) % TPL; mat = 0; \
            while (r_ >= kNT[mat] * kKT[mat]) { r_ -= kNT[mat] * kKT[mat]; ++mat; } \
            const int kT_ = kKT[mat]; dofs = (size_t)kDO[mat]; \
            n0 = (r_ / kT_) * 64; k0 = (r_ % kT_) * 128; K = kT_ * 128; \
            l = __builtin_amdgcn_readfirstlane(l); mat = __builtin_amdgcn_readfirstlane(mat); n0 = __builtin_amdgcn_readfirstlane(n0); k0 = __builtin_amdgcn_readfirstlane(k0); K = __builtin_amdgcn_readfirstlane(K); \
            _Pragma("unroll") for (int i = 0; i < 16; ++i) v[i] = w_fetch(P, l, mat, n0 + nn, k0 + kq + 8 * i); } while (0)
        int t = blockIdx.x, buf = 0;
        if (t < 2 * TPL) PRO_DEC(t);
        while (t < 2 * TPL) {
            float* tl_ = tile + buf * (128 * 65);
#pragma unroll
            for (int i = 0; i < 16; ++i) tl_[(kq + 8 * i) * 65 + nn] = v[i];
            u16* dst = Wall + (size_t)l * W_LAYER + dofs + (size_t)(n0 + (tid >> 3)) * K + k0 + (tid & 7) * 16;
            const int tn = t + gridDim.x;
            if (tn < 2 * TPL) PRO_DEC(tn);
            __syncthreads();
            { const int n2 = tid >> 3, ks = tid & 7; float o[16];
#pragma unroll
              for (int j = 0; j < 16; ++j) o[j] = tl_[(ks * 16 + j) * 65 + n2];
              uint4 st0, st1; st0.x = cvt_pk_bf16(o[0], o[1]); st0.y = cvt_pk_bf16(o[2], o[3]); st0.z = cvt_pk_bf16(o[4], o[5]); st0.w = cvt_pk_bf16(o[6], o[7]);
              st1.x = cvt_pk_bf16(o[8], o[9]); st1.y = cvt_pk_bf16(o[10], o[11]); st1.z = cvt_pk_bf16(o[12], o[13]); st1.w = cvt_pk_bf16(o[14], o[15]);
              *(uint4*)dst = st0; *(uint4*)(dst + 8) = st1; }
            buf ^= 1; t = tn;
        }
#undef PRO_DEC
        __syncthreads();
    }
    { float* ssz = (float*)(P->ws + WS_SS); for (int i = blockIdx.x * 512 + tid; i < 6 * NTOK; i += gridDim.x * 512) ssz[i] = 0.f; }
    float* condT = (float*)shm;
    float* red = (float*)shm;
    float* modo = (float*)(P->ws + WS_MOD);
    const int wave = tid >> 6, lane = tid & 63;
    for (int it = blockIdx.x; it < 288; it += gridDim.x) {
        const int l = it / 144, cg0 = (it % 144) * 64;
        for (int i = tid; i < 32768; i += 512) { const int b = i >> 10, k = i & 1023; condT[k * 32 + b] = siluf_(P->in[1][i]); }
        __syncthreads();
        float acc[32];
#pragma unroll
        for (int b = 0; b < 32; ++b) acc[b] = 0.f;
        const float* wp = P->in[3] + ((size_t)l * 1024 + wave * 128) * 9216 + cg0 + lane;
        for (int k = 0; k < 128; k += 8) {
            float w8[8];
#pragma unroll
            for (int j = 0; j < 8; ++j) w8[j] = wp[(size_t)(k + j) * 9216];
#pragma unroll
            for (int j = 0; j < 8; ++j) { const float w = w8[j];
                const f32x4* cp = (const f32x4*)(condT + (wave * 128 + k + j) * 32);
#pragma unroll
                for (int q = 0; q < 8; ++q) { const f32x4 c4 = cp[q]; acc[q * 4 + 0] += c4[0] * w; acc[q * 4 + 1] += c4[1] * w; acc[q * 4 + 2] += c4[2] * w; acc[q * 4 + 3] += c4[3] * w; } }
        }
        __syncthreads();
#pragma unroll
        for (int b = 0; b < 32; ++b) red[(wave * 32 + b) * 64 + lane] = acc[b];
        __syncthreads();
#pragma unroll
        for (int i = 0; i < 4; ++i) { const int o = tid + 512 * i, b = o >> 6, cl = o & 63; float s = P->in[4][(size_t)l * 9216 + cg0 + cl];
#pragma unroll
            for (int w = 0; w < 8; ++w) s += red[(w * 32 + b) * 64 + cl];
            modo[((size_t)l * 32 + b) * 9216 + cg0 + cl] = s; }
        __syncthreads();
    }
}

__device__ __forceinline__ void phase_norm0_sw(KP P, unsigned char* shm) {
    const int tid = ltid(), lane = tid & 63, wave = tid >> 6, gw = blockIdx.x * 8 + wave, nw = gridDim.x * 8;
    const float* modall = (const float*)(P->ws + WS_MOD);
    {
        const float* nwp = P->in[5];
        u16* U = (u16*)(P->ws + WS_U);
        float* ss0 = (float*)(P->ws + WS_SS);
        const float* h = P->in[0];
        f32x4 wv[4];
#pragma unroll
        for (int i = 0; i < 4; ++i) wv[i] = *(const f32x4*)(nwp + 4 * (lane + 64 * i));
        for (int rowb = gw; rowb < NTOK; rowb += 2 * nw) {
            f32x4 v[2][4];
#pragma unroll
            for (int rr = 0; rr < 2; ++rr) { const int row = rowb + rr * nw; if (row < NTOK) {
#pragma unroll
                for (int i = 0; i < 4; ++i) v[rr][i] = *(const f32x4*)(h + (size_t)row * DM + 4 * (lane + 64 * i)); } }
#pragma unroll
            for (int rr = 0; rr < 2; ++rr) { const int row = rowb + rr * nw; if (row < NTOK) {
                const float* scp = modall + (size_t)(row >> 11) * 9216 + 1024;
                float ss = 0.f;
#pragma unroll
                for (int i = 0; i < 4; ++i) ss += v[rr][i][0] * v[rr][i][0] + v[rr][i][1] * v[rr][i][1] + v[rr][i][2] * v[rr][i][2] + v[rr][i][3] * v[rr][i][3];
                ss = wave_sum(ss);
                if (lane == 0) ss0[row] = ss;
#pragma unroll
                for (int i = 0; i < 4; ++i) { const int c = 4 * (lane + 64 * i);
                    const f32x4 y = v[rr][i] * wv[i] * (*(const f32x4*)(scp + c) + 1.f);
                    uint2 st; st.x = cvt_pk_bf16(y[0], y[1]); st.y = cvt_pk_bf16(y[2], y[3]);
                    *(uint2*)(U + (size_t)row * DM + c) = st; } } }
        }
    }
    __syncthreads();
    float* shT = (float*)shm;
    float* red = (float*)shm;
    float* SWall = (float*)(P->ws + WS_SW);
    const int MATS[6] = {0, 1, 4, 5, 6, 7}, GRP[6] = {88, 88, 24, 32, 32, 48}, NN[6] = {5632, 5632, 1536, 2048, 2048, 3072};
    const size_t SO[6] = {SW_GU0, SW_GU1, SW_INA, SW_INB, SW_INC, SW_G};
    for (int it = blockIdx.x; it < 624; it += gridDim.x) {
        const int l = it / 312; int r = it % 312, mi = 0;
#pragma unroll
        for (int i = 0; i < 6; ++i) if (mi == i && r >= GRP[i]) { r -= GRP[i]; mi = i + 1; }
        int mat = 0, N = 0; size_t so = 0;
#pragma unroll
        for (int i = 0; i < 6; ++i) if (mi == i) { mat = MATS[i]; N = NN[i]; so = SO[i]; }
        const int sub = mat == 0 ? 0 : (mat == 1 ? 2 : 1), n0 = r * 64;
        const float* shp = modall + (size_t)l * 32 * 9216 + (3 * sub) * 1024;
        for (int i = tid; i < 32768; i += 512) { const int b = i >> 10, k = i & 1023; shT[k * 32 + b] = shp[(size_t)b * 9216 + k]; }
        __syncthreads();
        float acc[32];
#pragma unroll
        for (int b = 0; b < 32; ++b) acc[b] = 0.f;
        for (int k = 0; k < 128; k += 8) {
            float w8[8];
#pragma unroll
            for (int j = 0; j < 8; ++j) w8[j] = w_fetch(P, l, mat, n0 + lane, wave * 128 + k + j);
#pragma unroll
            for (int j = 0; j < 8; ++j) { const float w = w8[j];
                const f32x4* cp = (const f32x4*)(shT + (wave * 128 + k + j) * 32);
#pragma unroll
                for (int q = 0; q < 8; ++q) { const f32x4 c4 = cp[q]; acc[q * 4 + 0] += c4[0] * w; acc[q * 4 + 1] += c4[1] * w; acc[q * 4 + 2] += c4[2] * w; acc[q * 4 + 3] += c4[3] * w; } }
        }
        __syncthreads();
#pragma unroll
        for (int b = 0; b < 32; ++b) red[(wave * 32 + b) * 64 + lane] = acc[b];
        __syncthreads();
        float* dst = SWall + (size_t)l * SW_LAYER + so;
#pragma unroll
        for (int i = 0; i < 4; ++i) { const int o = tid + 512 * i, b = o >> 6, cl = o & 63; float sum = 0.f;
#pragma unroll
            for (int w = 0; w < 8; ++w) sum += red[(w * 32 + b) * 64 + cl];
            dst[(size_t)b * N + n0 + cl] = sum; }
        __syncthreads();
    }
}

__device__ const double kInvRev[32] = {0.15915494309189535, 0.11934937021124886, 0.08949940160889101, 0.06711508300522726, 0.050329212104487035, 0.03774158471741977, 0.0283021958306234, 0.02122365276477766, 0.015915494309189534, 0.011934937021124886, 0.008949940160889102, 0.006711508300522725, 0.005032921210448704, 0.003774158471741977, 0.00283021958306234, 0.0021223652764777662, 0.0015915494309189536, 0.0011934937021124885, 0.0008949940160889102, 0.0006711508300522726, 0.0005032921210448703, 0.00037741584717419774, 0.00028302195830623395, 0.0002122365276477766, 0.00015915494309189535, 0.00011934937021124886, 8.949940160889102e-05, 6.711508300522725e-05, 5.0329212104487035e-05, 3.774158471741978e-05, 2.8302195830623396e-05, 2.122365276477766e-05};
__device__ __forceinline__ void phase_attn_prep(KP P, int l_, unsigned char* shm) {
    const int l = lsg(l_);
    const int tid_ = ltid(), lane = tid_ & 63, gw = blockIdx.x * 8 + (tid_ >> 6), nw = gridDim.x * 8;
    u16* pA = (u16*)(P->ws + WS_P);
    const int vi = lane >> 2, sq = lane & 3;
    const float* qkw = P->in[10] + (size_t)(l * 2 + (vi >> 3)) * 64 + sq * 8;
    float w1[8], w2[8];
#pragma unroll
    for (int j = 0; j < 8; ++j) { w1[j] = qkw[j]; w2[j] = qkw[32 + j]; }
    const float qs = (vi < 8) ? 0.125f * 1.4426950408889634f : 1.f;
    for (int rowb = gw; rowb < NTOK; rowb += 2 * nw) {
      uint4 la[2], lb[2]; int lpos[2];
#pragma unroll
      for (int i = 0; i < 2; ++i) { const int row = rowb + i * nw; if (row < NTOK) { const u16* p = pA + (size_t)row * 1536 + vi * 64 + sq * 8; la[i] = *(const uint4*)p; lb[i] = *(const uint4*)(p + 32); lpos[i] = ((const int*)P->in[2])[row]; } }
#pragma unroll
      for (int i = 0; i < 2; ++i) { const int row = rowb + i * nw; if (row < NTOK) {
        u16* p = pA + (size_t)row * 1536 + vi * 64 + sq * 8;
        const uint4 a = la[i], bq = lb[i];
        float t1[8] = {bflo(a.x), bfhi(a.x), bflo(a.y), bfhi(a.y), bflo(a.z), bfhi(a.z), bflo(a.w), bfhi(a.w)};
        float t2[8] = {bflo(bq.x), bfhi(bq.x), bflo(bq.y), bfhi(bq.y), bflo(bq.z), bfhi(bq.z), bflo(bq.w), bfhi(bq.w)};
        float ss = 0.f;
#pragma unroll
        for (int j = 0; j < 8; ++j) ss += t1[j] * t1[j] + t2[j] * t2[j];
        ss += dpp_f<0xB1>(ss); ss += dpp_f<0x4E>(ss);
        const float rstd = __builtin_amdgcn_rsqf(ss * (1.f / 64.f) + 1e-6f) * qs;
        const double pos = (double)lpos[i];
        float o1[8], o2[8];
#pragma unroll
        for (int j = 0; j < 8; ++j) {
            const double rev = pos * kInvRev[sq * 8 + j];
            const float fr = (float)(rev - rint(rev));
            const float sn = __builtin_amdgcn_sinf(fr), cs = __builtin_amdgcn_cosf(fr);
            const float n1 = t1[j] * rstd * w1[j], n2 = t2[j] * rstd * w2[j];
            o1[j] = n1 * cs - n2 * sn; o2[j] = n2 * cs + n1 * sn;
        }
        uint4 s1, s2;
        s1.x = cvt_pk_bf16(o1[0], o1[1]); s1.y = cvt_pk_bf16(o1[2], o1[3]); s1.z = cvt_pk_bf16(o1[4], o1[5]); s1.w = cvt_pk_bf16(o1[6], o1[7]);
        s2.x = cvt_pk_bf16(o2[0], o2[1]); s2.y = cvt_pk_bf16(o2[2], o2[3]); s2.z = cvt_pk_bf16(o2[4], o2[5]); s2.w = cvt_pk_bf16(o2[6], o2[7]);
        *(uint4*)p = s1; *(uint4*)(p + 32) = s2;
      } }
    }
    {
        u16* vT = (u16*)(P->ws + WS_LO);
        u16* tile = (u16*)shm;
        const int ts = tid_ >> 3, tc = tid_ & 7;
        const int te = tid_ >> 2, tq = tid_ & 3;
        for (int it = blockIdx.x; it < 4096; it += gridDim.x) {
            const int bh = it >> 5, sb = it & 31, b = bh >> 2, h = bh & 3;
            const u16* src = pA + ((size_t)b * SEQ + sb * 64 + ts) * 1536 + 1024 + h * 128 + tc * 16;
            const uint4 a0 = *(const uint4*)src, a1 = *(const uint4*)(src + 8);
            *(uint4*)(tile + ts * 136 + tc * 16) = a0; *(uint4*)(tile + ts * 136 + tc * 16 + 8) = a1;
            __syncthreads();
            unsigned w[8];
#pragma unroll
            for (int j = 0; j < 8; ++j) w[j] = (unsigned)tile[(tq * 16 + 2 * j) * 136 + te] | ((unsigned)tile[(tq * 16 + 2 * j + 1) * 136 + te] << 16);
            u16* dst = vT + ((size_t)bh * 128 + te) * SEQ + sb * 64 + tq * 16;
            uint4 o0, o1; o0.x = w[0]; o0.y = w[1]; o0.z = w[2]; o0.w = w[3]; o1.x = w[4]; o1.y = w[5]; o1.z = w[6]; o1.w = w[7];
            *(uint4*)dst = o0; *(uint4*)(dst + 8) = o1;
            __syncthreads();
        }
    }
}

__device__ __forceinline__ void phase_attn(KP P, int l_, unsigned char* shm) {
    const int l = lsg(l_);
    const int tid = ltid(), wave = tid >> 6, lane = tid & 63, mp = wave >> 2, rq = wave & 3, l15 = lane & 15, g = lane >> 4;
    const u16* pA = (const u16*)(P->ws + WS_P);
    u16* OA = (u16*)(P->ws + WS_O);
    constexpr int KROW = 72, VROW = 136, KT_B = 128 * KROW * 2, VT_B = 128 * VROW * 2, STG = 2 * KT_B + VT_B;
    const u16* vTg = (const u16*)(P->ws + WS_LO);
    const float lam_init = 0.8f - 0.6f * __expf(-0.3f * (float)l);
    float lam;
    { const float* lq = P->in[11] + (size_t)l * 256; const float s1 = wave_sum(lq[lane] * lq[64 + lane]), s2 = wave_sum(lq[128 + lane] * lq[192 + lane]); lam = __expf(s1) - __expf(s2) + lam_init; }
    for (int it = blockIdx.x; it < 4096; it += gridDim.x) {
        const int j = it & 255, pi = 15 - (it >> 8), bh = j >> 1, half = j & 1, b = bh >> 2, h = bh & 3;
        const int qb = (pi >> 1) * 4 + ((pi & 1) ? (half ? 2 : 3) : (half ? 1 : 0));
        const int q0 = qb * 64, nt = (qb >> 1) + 1;
        const size_t tok0 = (size_t)b * SEQ;
        bf16x8 qf[2];
        { const u16* qp = pA + (tok0 + q0 + rq * 16 + l15) * 1536 + h * 128 + mp * 64 + g * 8;
          qf[0] = *(const bf16x8*)qp; qf[1] = *(const bf16x8*)(qp + 32); }
        f32x4 ot[8];
#pragma unroll
        for (int e = 0; e < 8; ++e) ot[e] = (f32x4){0.f, 0.f, 0.f, 0.f};
        float mrun = -INFINITY, lrun = 0.f;
        uint4 kreg0, kreg1, kreg2, kreg3, vreg0, vreg1, vreg2, vreg3;
        const int kc_key = (tid >> 3) & 63, kc_ch = tid & 7, vc_e = tid >> 4, vc_ch = tid & 15;
        const u16* kgb = pA + (tok0 + kc_key) * 1536 + 512 + h * 128 + kc_ch * 8;
        const u16* vTb = vTg + ((size_t)bh * 128 + vc_e) * SEQ + vc_ch * 8;
#define ATT_GLOAD(t_) do { const u16* kp_ = kgb + (size_t)(t_) * 128 * 1536; \
            kreg0 = *(const uint4*)(kp_); kreg1 = *(const uint4*)(kp_ + (size_t)64 * 1536); kreg2 = *(const uint4*)(kp_ + 64); kreg3 = *(const uint4*)(kp_ + (size_t)64 * 1536 + 64); \
            const u16* vp_ = vTb + (size_t)(t_) * 128; \
            vreg0 = *(const uint4*)(vp_); vreg1 = *(const uint4*)(vp_ + (size_t)32 * SEQ); vreg2 = *(const uint4*)(vp_ + (size_t)64 * SEQ); vreg3 = *(const uint4*)(vp_ + (size_t)96 * SEQ); } while (0)
#define ATT_LSTORE(st_) do { unsigned char* base_ = shm + (st_) * STG; \
            u16* k0_ = (u16*)base_ + kc_key * KROW + kc_ch * 8; \
            *(uint4*)k0_ = kreg0; *(uint4*)(k0_ + 64 * KROW) = kreg1; *(uint4*)(k0_ + 128 * KROW) = kreg2; *(uint4*)(k0_ + 192 * KROW) = kreg3; \
            u16* vt_ = (u16*)(base_ + 2 * KT_B) + vc_e * VROW + vc_ch * 8; \
            *(uint4*)vt_ = vreg0; *(uint4*)(vt_ + 32 * VROW) = vreg1; *(uint4*)(vt_ + 64 * VROW) = vreg2; *(uint4*)(vt_ + 96 * VROW) = vreg3; } while (0)
        ATT_GLOAD(0); ATT_LSTORE(0); __syncthreads();
        for (int t = 0; t < nt; ++t) {
            if (t + 1 < nt) ATT_GLOAD(t + 1);
            const unsigned char* base = shm + (t & 1) * STG;
#pragma unroll
            for (int hf = 0; hf < 2; ++hf) {
                const int kb = 2 * t + hf;
                if (kb <= qb) {
                    const u16* Ks = (const u16*)(base + mp * KT_B) + hf * 64 * KROW;
                    const u16* Vt = (const u16*)(base + 2 * KT_B) + hf * 64;
                    f32x4 st[4];
                    bf16x8 kfr[4][2];
#pragma unroll
                    for (int kt = 0; kt < 4; ++kt)
#pragma unroll
                        for (int ks = 0; ks < 2; ++ks) kfr[kt][ks] = *(const bf16x8*)(Ks + (kt * 16 + l15) * KROW + ks * 32 + g * 8);
                    uint2 vfa[8][2], vfb[8][2];
#pragma unroll
                    for (int e = 0; e < 8; ++e)
#pragma unroll
                        for (int k2 = 0; k2 < 2; ++k2) { const u16* vp = Vt + (e * 16 + l15) * VROW + k2 * 32 + g * 4; vfa[e][k2] = *(const uint2*)vp; vfb[e][k2] = *(const uint2*)(vp + 16); }
                    __builtin_amdgcn_sched_barrier(0);
#pragma unroll
                    for (int kt = 0; kt < 4; ++kt) { st[kt] = (f32x4){0.f, 0.f, 0.f, 0.f};
#pragma unroll
                        for (int ks = 0; ks < 2; ++ks) st[kt] = __builtin_amdgcn_mfma_f32_16x16x32_bf16(kfr[kt][ks], qf[ks], st[kt], 0, 0, 0); }
                    if (kb == qb) {
                        asm volatile("" ::: "memory");
                        const int qr = rq * 16 + l15;
#pragma unroll
                        for (int kt = 0; kt < 4; ++kt)
#pragma unroll
                            for (int jj = 0; jj < 4; ++jj) if (kt * 16 + g * 4 + jj > qr) st[kt][jj] = -INFINITY;
                    }
                    float mloc = st[0][0];
#pragma unroll
                    for (int kt = 0; kt < 4; ++kt)
#pragma unroll
                        for (int jj = 0; jj < 4; ++jj) mloc = fmaxf(mloc, st[kt][jj]);
                    mloc = fmaxf(mloc, shfl_xor_l(mloc, 16, lane)); mloc = fmaxf(mloc, shfl_xor_l(mloc, 32, lane));
                    const float mnew = fmaxf(mrun, mloc), alpha = __builtin_amdgcn_exp2f(mrun - mnew);
                    mrun = mnew;
                    float psum = 0.f;
#pragma unroll
                    for (int kt = 0; kt < 4; ++kt)
#pragma unroll
                        for (int jj = 0; jj < 4; ++jj) { const float p = __builtin_amdgcn_exp2f(st[kt][jj] - mnew); st[kt][jj] = p; psum += p; }
                    lrun = lrun * alpha + psum;
#pragma unroll
                    for (int e = 0; e < 8; ++e) ot[e] *= alpha;
                    bf16x8 pb[2];
#pragma unroll
                    for (int k2 = 0; k2 < 2; ++k2) { uint4 pk; pk.x = cvt_pk_bf16(st[2 * k2][0], st[2 * k2][1]); pk.y = cvt_pk_bf16(st[2 * k2][2], st[2 * k2][3]);
                        pk.z = cvt_pk_bf16(st[2 * k2 + 1][0], st[2 * k2 + 1][1]); pk.w = cvt_pk_bf16(st[2 * k2 + 1][2], st[2 * k2 + 1][3]);
                        pb[k2] = as_bf16x8(pk); }
#pragma unroll
                    for (int e = 0; e < 8; ++e)
#pragma unroll
                        for (int k2 = 0; k2 < 2; ++k2) { const uint2 v0 = vfa[e][k2], v1 = vfb[e][k2];
                            uint4 vv; vv.x = v0.x; vv.y = v0.y; vv.z = v1.x; vv.w = v1.y;
                            ot[e] = __builtin_amdgcn_mfma_f32_16x16x32_bf16(as_bf16x8(vv), pb[k2], ot[e], 0, 0, 0); }
                }
            }
            if (t + 1 < nt) ATT_LSTORE((t + 1) & 1);
            __syncthreads();
        }
#undef ATT_GLOAD
#undef ATT_LSTORE
        lrun += shfl_xor_l(lrun, 16, lane); lrun += shfl_xor_l(lrun, 32, lane);
        const float inv = __builtin_amdgcn_rcpf(lrun);
        float* X = (float*)shm;
        if (mp == 1) {
#pragma unroll
            for (int e = 0; e < 8; ++e)
#pragma unroll
                for (int jj = 0; jj < 4; ++jj) X[(rq * 128 + e * 16 + g * 4 + jj) * 16 + l15] = ot[e][jj] * inv * lam;
        }
        __syncthreads();
        if (mp == 0) {
            float ss = 0.f;
#pragma unroll
            for (int e = 0; e < 8; ++e)
#pragma unroll
                for (int jj = 0; jj < 4; ++jj) { const float o = ot[e][jj] * inv - X[(rq * 128 + e * 16 + g * 4 + jj) * 16 + l15]; ot[e][jj] = o; ss += o * o; }
            ss += shfl_xor_l(ss, 16, lane); ss += shfl_xor_l(ss, 32, lane);
            const float rstd = __builtin_amdgcn_rsqf(ss * (1.f / 128.f) + 1e-6f) * (1.f - lam_init);
            const float* sw = P->in[12] + (size_t)l * 128;
            u16* op = OA + (tok0 + q0 + rq * 16 + l15) * 512 + h * 128;
#pragma unroll
            for (int e = 0; e < 8; ++e) { const int e0 = e * 16 + g * 4; const f32x4 w4 = *(const f32x4*)(sw + e0);
                uint2 stv; stv.x = cvt_pk_bf16(ot[e][0] * rstd * w4[0], ot[e][1] * rstd * w4[1]); stv.y = cvt_pk_bf16(ot[e][2] * rstd * w4[2], ot[e][3] * rstd * w4[3]);
                *(uint2*)(op + e0) = stv; }
        }
        __syncthreads();
    }
}

__device__ __forceinline__ void phase_lora_prep(KP P, int l_) {
    const int l = lsg(l_);
    const int tid_ = ltid(), lane = tid_ & 63, gw = blockIdx.x * 8 + (tid_ >> 6), nw = gridDim.x * 8;
    const u16* pB = (const u16*)(P->ws + WS_P);
    unsigned* Ap = (unsigned*)(P->ws + WS_O);
    const float* mu = P->in[14] + (size_t)l * 1824 + 1536;
    float mu0[3], mu1[3];
#pragma unroll
    for (int q = 0; q < 3; ++q) { const int c = 2 * (lane + 64 * q); mu0[q] = c < 288 ? mu[c] : 0.f; mu1[q] = c < 288 ? mu[c + 1] : 0.f; }
    for (int row0 = gw * 4; row0 < NTOK; row0 += nw * 4) {
        unsigned ld[5][3];
#pragma unroll
        for (int r = 0; r < 5; ++r)
#pragma unroll
            for (int q = 0; q < 3; ++q) { const int c = 2 * (lane + 64 * q); const int row = row0 - 1 + r;
                ld[r][q] = (c < 288 && (r > 0 || (row0 & 2047) != 0)) ? *(const unsigned*)(pB + (size_t)row * 2048 + 1536 + c) : 0u; }
#pragma unroll
        for (int r = 1; r < 5; ++r)
#pragma unroll
            for (int q = 0; q < 3; ++q) { const int c = 2 * (lane + 64 * q);
                unsigned outw = 0u;
                if (c < 288) { const unsigned cur = ld[r][q], prv = ld[r - 1][q];
                    float x0 = bflo(cur), x1 = bfhi(cur);
                    x0 += (bflo(prv) - x0) * mu0[q]; x1 += (bfhi(prv) - x1) * mu1[q];
                    if (c < 64) { x0 = tanhf_(x0); x1 = tanhf_(x1); } else if (c >= 128) { x0 = sigmoidf_(x0); x1 = sigmoidf_(x1); }
                    outw = cvt_pk_bf16(x0, x1); }
                Ap[(size_t)(row0 - 1 + r) * 192 + lane + 64 * q] = outw; }
    }
}

__device__ __forceinline__ void phase_rwkv(KP P, int l_, unsigned char* shm) {
    const int l = lsg(l_);
    const int tid = ltid(), wave = __builtin_amdgcn_readfirstlane(tid >> 6), lane = tid & 63;
    const int rp = (tid & 255) >> 3, seg = tid & 7, pw = wave & 3;
    const bool scanw = wave < 4;
    const u16* pB = (const u16*)(P->ws + WS_P);
    const u16* LO = (const u16*)(P->ws + WS_LO);
    u16* OB = (u16*)(P->ws + WS_O);
    constexpr int T = 32, NC = SEQ / T, CS = 5 * T * 64;
    float* sCoef = (float*)shm;
    float* sV = sCoef + 2 * CS;
    float* sG = sV + 3 * T * 64;
    float* sO = sG + 2 * T * 64;
    float* sBon = sO + 2 * T * 64;
    for (int bh = blockIdx.x; bh < 256; bh += gridDim.x) {
        const int b = bh >> 3, h = bh & 7, ch = h * 64 + lane;
        const float mu_r = P->in[14][(size_t)l * 1824 + ch], mu_k = P->in[14][(size_t)l * 1824 + 512 + ch], mu_v = P->in[14][(size_t)l * 1824 + 1024 + ch];
        const float kkw = P->in[20][(size_t)l * 512 + ch], kaw = P->in[21][(size_t)l * 512 + ch], rkw = P->in[22][(size_t)l * 512 + ch];
        const float lnw = P->in[23][(size_t)l * 512 + ch], lnb = P->in[24][(size_t)l * 512 + ch];
        const float w0c = P->in[15][(size_t)l * 512 + ch], a0c = P->in[17][(size_t)l * 512 + ch];
        f32x2 sa[4], sb[4];
#pragma unroll
        for (int jj = 0; jj < 4; ++jj) { sa[jj] = (f32x2){0.f, 0.f}; sb[jj] = (f32x2){0.f, 0.f}; }
        unsigned short gr[9], gk[9], gv[9], gw[8], ga[8], gg[8];
#define RW_LOAD(c_) do { const int tb_ = (c_) * T + pw * 8; \
            _Pragma("unroll") for (int i = 0; i < 9; ++i) { const int t_ = tb_ + i - 1; \
                if (t_ >= 0) { const u16* pc_ = pB + ((size_t)b * SEQ + t_) * 2048 + ch; gr[i] = pc_[0]; gk[i] = pc_[512]; gv[i] = pc_[1024]; } else { gr[i] = 0; gk[i] = 0; gv[i] = 0; } } \
            _Pragma("unroll") for (int i = 0; i < 8; ++i) { const u16* lp_ = LO + ((size_t)b * SEQ + tb_ + i) * 1536 + ch; gw[i] = lp_[0]; ga[i] = lp_[512]; gg[i] = lp_[1024]; } } while (0)
#define RW_PREP(c_) do { float* cf_ = sCoef + ((c_) & 1) * CS; float* vv_ = sV + ((c_) % 3) * T * 64; float* gg_ = sG + ((c_) & 1) * T * 64; \
            _Pragma("unroll") for (int i = 0; i < 8; ++i) { const int tl_ = pw * 8 + i; \
                float r_ = bf2f(gr[i + 1]), k_ = bf2f(gk[i + 1]), v_ = bf2f(gv[i + 1]); \
                r_ += (bf2f(gr[i]) - r_) * mu_r; k_ += (bf2f(gk[i]) - k_) * mu_k; v_ += (bf2f(gv[i]) - v_) * mu_v; \
                const float dec_ = __expf(-0.60653066f * sigmoidf_(w0c + bf2f(gw[i]))); \
                const float a_ = sigmoidf_(a0c + bf2f(ga[i])); \
                const float kr_ = k_ * kkw; \
                const float kk_ = kr_ * __builtin_amdgcn_rsqf(fmaxf(wave_sum(kr_ * kr_), 1e-24f));     \
                const float km_ = k_ * (1.f + (a_ - 1.f) * kaw); \
                const float bon_ = wave_sum(r_ * km_ * rkw); \
                cf_[tl_ * 64 + lane] = dec_; cf_[T * 64 + tl_ * 64 + lane] = kk_; cf_[2 * T * 64 + tl_ * 64 + lane] = kk_ * a_; cf_[3 * T * 64 + tl_ * 64 + lane] = km_; cf_[4 * T * 64 + tl_ * 64 + lane] = r_; \
                vv_[tl_ * 64 + lane] = v_; gg_[tl_ * 64 + lane] = bf2f(gg[i]); \
                if (lane == 0) sBon[((c_) % 3) * T + tl_] = bon_; } } while (0)
#define RW_POST(c_) do { const float* vv_ = sV + ((c_) % 3) * T * 64; const float* gg_ = sG + ((c_) & 1) * T * 64; const float* oo_ = sO + ((c_) & 1) * T * 64; \
            _Pragma("unroll") for (int i = 0; i < 8; ++i) { const int tl_ = pw * 8 + i; const size_t tok_ = (size_t)b * SEQ + (c_) * T + tl_; \
                const float o_ = oo_[tl_ * 64 + lane]; \
                const float mean_ = wave_sum(o_) * (1.f / 64.f); \
                const float dd_ = o_ - mean_; \
                const float var_ = wave_sum(dd_ * dd_) * (1.f / 64.f); \
                float y_ = dd_ * __builtin_amdgcn_rsqf(var_ + 64e-5f) * lnw + lnb; \
                y_ += sBon[((c_) % 3) * T + tl_] * vv_[tl_ * 64 + lane]; \
                OB[tok_ * 512 + ch] = f2bf(y_ * gg_[tl_ * 64 + lane]); } } while (0)
        __syncthreads();
        if (!scanw) { RW_LOAD(0); RW_PREP(0); RW_LOAD(1); }
        __syncthreads();
        for (int c = 0; c < NC; ++c) {
            if (scanw) {
                const float* cf = sCoef + (c & 1) * CS; const float* vb = sV + (c % 3) * T * 64; float* ob = sO + (c & 1) * T * 64;
#define RW_LD(X, tl_) do { const float* q_ = cf + (tl_) * 64 + seg * 8; \
                X##w0 = *(const f32x4*)(q_); X##w1 = *(const f32x4*)(q_ + 4); \
                X##kk0 = *(const f32x4*)(q_ + T * 64); X##kk1 = *(const f32x4*)(q_ + T * 64 + 4); \
                X##b0 = *(const f32x4*)(q_ + 2 * T * 64); X##b1 = *(const f32x4*)(q_ + 2 * T * 64 + 4); \
                X##k0 = *(const f32x4*)(q_ + 3 * T * 64); X##k1 = *(const f32x4*)(q_ + 3 * T * 64 + 4); \
                X##r0 = *(const f32x4*)(q_ + 4 * T * 64); X##r1 = *(const f32x4*)(q_ + 4 * T * 64 + 4); \
                X##va = vb[(tl_) * 64 + rp]; X##vb = vb[(tl_) * 64 + 32 + rp]; } while (0)
#define RW_STEP(X, tl_) do {   \
                const f32x2 kk0l_ = (f32x2){X##kk0[0], X##kk0[1]}, kk0h_ = (f32x2){X##kk0[2], X##kk0[3]}, kk1l_ = (f32x2){X##kk1[0], X##kk1[1]}, kk1h_ = (f32x2){X##kk1[2], X##kk1[3]}; \
                f32x2 da_ = sa[0] * kk0l_ + sa[1] * kk0h_; f32x2 db_ = sb[0] * kk0l_ + sb[1] * kk0h_; \
                f32x2 ea_ = sa[2] * kk1l_ + sa[3] * kk1h_; f32x2 eb_ = sb[2] * kk1l_ + sb[3] * kk1h_; \
                da_ += ea_; db_ += eb_; \
                float ka_ = da_[0] + da_[1], kb_ = db_[0] + db_[1]; \
                ka_ += dpp_f<0xB1>(ka_); kb_ += dpp_f<0xB1>(kb_); ka_ += dpp_f<0x4E>(ka_); kb_ += dpp_f<0x4E>(kb_); ka_ += dpp_f<0x141>(ka_); kb_ += dpp_f<0x141>(kb_); \
                const f32x2 na_ = (f32x2){-ka_, -ka_}, nb_ = (f32x2){-kb_, -kb_}, va_ = (f32x2){X##va, X##va}, vb_ = (f32x2){X##vb, X##vb}; \
                const f32x2 w0l_ = (f32x2){X##w0[0], X##w0[1]}, w0h_ = (f32x2){X##w0[2], X##w0[3]}, w1l_ = (f32x2){X##w1[0], X##w1[1]}, w1h_ = (f32x2){X##w1[2], X##w1[3]}; \
                const f32x2 b0l_ = (f32x2){X##b0[0], X##b0[1]}, b0h_ = (f32x2){X##b0[2], X##b0[3]}, b1l_ = (f32x2){X##b1[0], X##b1[1]}, b1h_ = (f32x2){X##b1[2], X##b1[3]}; \
                const f32x2 k0l_ = (f32x2){X##k0[0], X##k0[1]}, k0h_ = (f32x2){X##k0[2], X##k0[3]}, k1l_ = (f32x2){X##k1[0], X##k1[1]}, k1h_ = (f32x2){X##k1[2], X##k1[3]}; \
                sa[0] = sa[0] * w0l_ + na_ * b0l_ + va_ * k0l_; sb[0] = sb[0] * w0l_ + nb_ * b0l_ + vb_ * k0l_; \
                sa[1] = sa[1] * w0h_ + na_ * b0h_ + va_ * k0h_; sb[1] = sb[1] * w0h_ + nb_ * b0h_ + vb_ * k0h_; \
                sa[2] = sa[2] * w1l_ + na_ * b1l_ + va_ * k1l_; sb[2] = sb[2] * w1l_ + nb_ * b1l_ + vb_ * k1l_; \
                sa[3] = sa[3] * w1h_ + na_ * b1h_ + va_ * k1h_; sb[3] = sb[3] * w1h_ + nb_ * b1h_ + vb_ * k1h_; \
                const f32x2 r0l_ = (f32x2){X##r0[0], X##r0[1]}, r0h_ = (f32x2){X##r0[2], X##r0[3]}, r1l_ = (f32x2){X##r1[0], X##r1[1]}, r1h_ = (f32x2){X##r1[2], X##r1[3]}; \
                f32x2 oa_ = sa[0] * r0l_ + sa[1] * r0h_; f32x2 ob_ = sb[0] * r0l_ + sb[1] * r0h_; \
                f32x2 pa_ = sa[2] * r1l_ + sa[3] * r1h_; f32x2 pb_ = sb[2] * r1l_ + sb[3] * r1h_; \
                oa_ += pa_; ob_ += pb_; \
                float ta_ = oa_[0] + oa_[1], tb_ = ob_[0] + ob_[1]; \
                ta_ += dpp_f<0xB1>(ta_); tb_ += dpp_f<0xB1>(tb_); ta_ += dpp_f<0x4E>(ta_); tb_ += dpp_f<0x4E>(tb_); ta_ += dpp_f<0x141>(ta_); tb_ += dpp_f<0x141>(tb_); \
                if (seg == 0) { ob[(tl_) * 64 + rp] = ta_; ob[(tl_) * 64 + rp + 32] = tb_; } } while (0)
                f32x4 Aw0, Aw1, Akk0, Akk1, Ab0, Ab1, Ak0, Ak1, Ar0, Ar1; float Ava, Avb;
                f32x4 Bw0, Bw1, Bkk0, Bkk1, Bb0, Bb1, Bk0, Bk1, Br0, Br1; float Bva, Bvb;
                RW_LD(A, 0);
#pragma unroll 2
                for (int tl = 0; tl < T; tl += 2) {
                    RW_LD(B, tl + 1);
                    RW_STEP(A, tl);
                    RW_LD(A, tl + 2);
                    RW_STEP(B, tl + 1);
                }
#undef RW_LD
#undef RW_STEP
            } else {
                if (c >= 1) RW_POST(c - 1);
                if (c + 1 < NC) { RW_PREP(c + 1); if (c + 2 < NC) RW_LOAD(c + 2); }
            }
            __syncthreads();
        }
        if (!scanw) RW_POST(NC - 1);
#undef RW_LOAD
#undef RW_PREP
#undef RW_POST
    }
}

__device__ __forceinline__ void phase_hgrn(KP P, int l_, unsigned char* shm) {
    const int l = lsg(l_);
    const int tid = ltid(), wave = tid >> 6, lane = tid & 63, cp = tid >> 4, seg = tid & 15;
    const u16* pC = (const u16*)(P->ws + WS_P);
    u16* OC = (u16*)(P->ws + WS_O);
    constexpr int T = 32;
    float* sF = (float*)shm; float* sQ = sF + T * 128; float* sDV = sQ + T * 128; float* sVN = sDV + T * 64; float* sO = sVN + T * 64; float* sQS = sO + T * 256;
    for (int it = blockIdx.x; it < 256; it += gridDim.x) {
        const int half = it & 1, h = (it >> 1) & 3, b = it >> 3;
        float lb0 = 0.f, lb1 = 0.f;
        if (l == 1) { const float* hl = P->in[26]; lb0 = sigmoidf_(hl[512 + h * 128 + lane] - hl[h * 128 + lane]); lb1 = sigmoidf_(hl[512 + h * 128 + 64 + lane] - hl[h * 128 + 64 + lane]); }
        const float v0a = bf2f(pC[((size_t)b * SEQ) * 2048 + h * 128 + 1024 + half * 64 + cp]), v0b = bf2f(pC[((size_t)b * SEQ) * 2048 + h * 128 + 1024 + half * 64 + cp + 32]);
        f32x2 ea[4], eb[4];
#pragma unroll
        for (int jj = 0; jj < 4; ++jj) { ea[jj] = (f32x2){-v0a, -v0a}; eb[jj] = (f32x2){-v0b, -v0b}; }
        unsigned short gq0[4], gq1[4], gf0[4], gf1[4], gvv[5];
#define HG_LOAD(c0_) do { _Pragma("unroll") for (int i = 0; i < 4; ++i) { const u16* pc_ = pC + ((size_t)b * SEQ + (c0_) + wave * 4 + i) * 2048 + h * 128 + lane; \
            gq0[i] = pc_[0]; gq1[i] = pc_[64]; gf0[i] = pc_[512]; gf1[i] = pc_[512 + 64]; gvv[i] = pc_[1024 + half * 64]; } \
            { const int tn_ = (c0_) + wave * 4 + 4; gvv[4] = tn_ < SEQ ? pC[((size_t)b * SEQ + tn_) * 2048 + h * 128 + lane + 1024 + half * 64] : (unsigned short)0; } } while (0)
#define HG_PREP() do { _Pragma("unroll") for (int i = 0; i < 4; ++i) { const int tl_ = wave * 4 + i; \
            const float q0_ = siluf_(bf2f(gq0[i])), q1_ = siluf_(bf2f(gq1[i])); \
            sQ[tl_ * 128 + lane] = q0_; sQ[tl_ * 128 + 64 + lane] = q1_; \
            sF[tl_ * 128 + lane] = lb0 + (1.f - lb0) * sigmoidf_(bf2f(gf0[i])); sF[tl_ * 128 + 64 + lane] = lb1 + (1.f - lb1) * sigmoidf_(bf2f(gf1[i])); \
            const float vn_ = bf2f(gvv[i + 1]); sDV[tl_ * 64 + lane] = bf2f(gvv[i]) - vn_; sVN[tl_ * 64 + lane] = vn_; \
            const float qs_ = wave_sum(q0_ + q1_); if (lane == 0) sQS[tl_] = qs_; } } while (0)
        HG_LOAD(0); HG_PREP();
        __syncthreads();
        for (int c = 0; c < SEQ / T; ++c) {
            if (c + 1 < SEQ / T) HG_LOAD((c + 1) * T);
#define HG_LD(X, tl_) do { const float* f_ = sF + (tl_) * 128 + seg * 4; const float* q_ = sQ + (tl_) * 128 + seg * 4;   \
                X##f0 = *(const f32x4*)(f_); X##f1 = *(const f32x4*)(f_ + 64); X##q0 = *(const f32x4*)(q_); X##q1 = *(const f32x4*)(q_ + 64); \
                X##va = sDV[(tl_) * 64 + cp]; X##vb = sDV[(tl_) * 64 + 32 + cp]; } while (0)
#define HG_STEP(X, tl_) do { const f32x2 da_ = (f32x2){X##va, X##va}, db_ = (f32x2){X##vb, X##vb}; \
                const f32x2 f0l_ = (f32x2){X##f0[0], X##f0[1]}, f0h_ = (f32x2){X##f0[2], X##f0[3]}, f1l_ = (f32x2){X##f1[0], X##f1[1]}, f1h_ = (f32x2){X##f1[2], X##f1[3]}; \
                const f32x2 q0l_ = (f32x2){X##q0[0], X##q0[1]}, q0h_ = (f32x2){X##q0[2], X##q0[3]}, q1l_ = (f32x2){X##q1[0], X##q1[1]}, q1h_ = (f32x2){X##q1[2], X##q1[3]}; \
                ea[0] = f0l_ * ea[0] + da_; eb[0] = f0l_ * eb[0] + db_; ea[1] = f0h_ * ea[1] + da_; eb[1] = f0h_ * eb[1] + db_; \
                ea[2] = f1l_ * ea[2] + da_; eb[2] = f1l_ * eb[2] + db_; ea[3] = f1h_ * ea[3] + da_; eb[3] = f1h_ * eb[3] + db_; \
                f32x2 oa_ = ea[0] * q0l_ + ea[1] * q0h_; f32x2 ob_ = eb[0] * q0l_ + eb[1] * q0h_; \
                oa_ += ea[2] * q1l_ + ea[3] * q1h_; ob_ += eb[2] * q1l_ + eb[3] * q1h_; \
                float pa_ = oa_[0] + oa_[1], pb_ = ob_[0] + ob_[1]; \
                pa_ += dpp_f<0xB1>(pa_); pb_ += dpp_f<0xB1>(pb_); pa_ += dpp_f<0x4E>(pa_); pb_ += dpp_f<0x4E>(pb_); \
                if ((seg & 3) == 0) { sO[(tl_) * 256 + cp * 4 + (seg >> 2)] = pa_; sO[(tl_) * 256 + (cp + 32) * 4 + (seg >> 2)] = pb_; } } while (0)
            {
                f32x4 Af0, Af1, Aq0, Aq1; float Ava, Avb;
                f32x4 Bf0, Bf1, Bq0, Bq1; float Bva, Bvb;
                HG_LD(A, 0);
#pragma unroll 2
                for (int tl = 0; tl < T; tl += 2) {
                    HG_LD(B, tl + 1);
                    HG_STEP(A, tl);
                    HG_LD(A, tl + 2);
                    HG_STEP(B, tl + 1);
                }
            }
#undef HG_LD
#undef HG_STEP
            __syncthreads();
#pragma unroll
            for (int i = 0; i < 4; ++i) { const int tl = wave * 4 + i; const size_t tok = (size_t)b * SEQ + c * T + tl;
                const f32x4 oa = *(const f32x4*)(sO + tl * 256 + lane * 4);
                const float o = ((oa[0] + oa[1]) + (oa[2] + oa[3])) + sVN[tl * 64 + lane] * sQS[tl];
                OC[tok * 512 + h * 128 + half * 64 + lane] = f2bf(o); }
            if (c + 1 < SEQ / T) HG_PREP();
            __syncthreads();
        }
#undef HG_LOAD
#undef HG_PREP
    }
}
__device__ __forceinline__ void phase_hgrn_post(KP P, int l_) {
    const int l = lsg(l_);
    const int tid_ = ltid(), lane = tid_ & 63, gw = blockIdx.x * 8 + (tid_ >> 6), nw = gridDim.x * 8;
    const u16* pC = (const u16*)(P->ws + WS_P);
    u16* OC = (u16*)(P->ws + WS_O);
    const float* nwp = P->in[27] + (size_t)l * 128 + (lane & 15) * 8;
    float w[8];
#pragma unroll
    for (int j = 0; j < 8; ++j) w[j] = nwp[j];
    for (int rowb = gw; rowb < NTOK; rowb += 4 * nw) {
        uint4 ovs[4], gvs[4];
#pragma unroll
        for (int i = 0; i < 4; ++i) { const int row = rowb + i * nw; if (row < NTOK) { ovs[i] = *(const uint4*)(OC + (size_t)row * 512 + lane * 8); gvs[i] = *(const uint4*)(pC + (size_t)row * 2048 + 1536 + lane * 8); } }
#pragma unroll
        for (int i = 0; i < 4; ++i) { const int row = rowb + i * nw; if (row < NTOK) {
            const uint4 ov = ovs[i], gv = gvs[i];
            float o[8] = {bflo(ov.x), bfhi(ov.x), bflo(ov.y), bfhi(ov.y), bflo(ov.z), bfhi(ov.z), bflo(ov.w), bfhi(ov.w)};
            const float gg[8] = {bflo(gv.x), bfhi(gv.x), bflo(gv.y), bfhi(gv.y), bflo(gv.z), bfhi(gv.z), bflo(gv.w), bfhi(gv.w)};
            float ss = 0.f;
#pragma unroll
            for (int j = 0; j < 8; ++j) ss += o[j] * o[j];
            ss += dpp_f<0xB1>(ss); ss += dpp_f<0x4E>(ss); ss += dpp_f<0x141>(ss); ss += dpp_f<0x140>(ss);
            const float rstd = __builtin_amdgcn_rsqf(ss * (1.f / 128.f) + 1e-6f);
#pragma unroll
            for (int j = 0; j < 8; ++j) o[j] = o[j] * rstd * w[j] * siluf_(gg[j]);
            uint4 st; st.x = cvt_pk_bf16(o[0], o[1]); st.y = cvt_pk_bf16(o[2], o[3]); st.z = cvt_pk_bf16(o[4], o[5]); st.w = cvt_pk_bf16(o[6], o[7]);
            *(uint4*)(OC + (size_t)row * 512 + lane * 8) = st; } }
    }
}

constexpr size_t WS_BAR = WS_MOD + 2816 * 1024;
#define XB_TMO      128
#define XB_XCNT(j)  (256  + 64 * (j))
#define XB_XSUB(j)  (1280 + 64 * (j))
#define XB_XGEN(j)  (2304 + 64 * (j))
#define XB_TOP      3328
#define XB_TOPGEN   3392
#define XCD_BAR_WORDS 3456
#define XB_SPIN_CAP (1u << 22)
__device__ __forceinline__ unsigned xb_ld(unsigned* p)              { return __hip_atomic_load(p, __ATOMIC_RELAXED, __HIP_MEMORY_SCOPE_AGENT); }
__device__ __forceinline__ unsigned xb_add(unsigned* p, unsigned v) { return __hip_atomic_fetch_add(p, v, __ATOMIC_RELAXED, __HIP_MEMORY_SCOPE_AGENT); }
__device__ __forceinline__ unsigned xb_xcc_id() { return (unsigned)__builtin_amdgcn_s_getreg((3 << 11) | 20) & 0xFu; }
#define XB_SPIN(cond, bar) do { unsigned _sp = 0; while (cond) { __builtin_amdgcn_s_sleep(1); \
    if ((++_sp & 255u) == 0u) { if (xb_ld(&(bar)[XB_TMO])) break; if (_sp > XB_SPIN_CAP) { atomicAdd(&(bar)[XB_TMO], 1u); break; } } } } while (0)
struct XcdBarrier { unsigned* bar; unsigned x; volatile LAS unsigned* st; };
__device__ __forceinline__ XcdBarrier xcd_barrier_post(unsigned* bar, volatile LAS unsigned* st) {
    XcdBarrier b; b.bar = bar; b.x = xb_xcc_id(); b.st = st;
    if (threadIdx.x == 0) (void)xb_add(&bar[XB_XCNT(b.x)], 1u);
    return b;
}
__device__ __forceinline__ void xcd_barrier_complete(unsigned* bar, unsigned x, unsigned& nloc, unsigned& nx) {
    const unsigned G = gridDim.x * gridDim.y * gridDim.z;
    unsigned sum, cnt, mine, sp = 0u;
    for (;;) {
        sum = 0u; cnt = 0u; mine = 0u;
#pragma unroll
        for (unsigned j = 0; j < 16; ++j) { const unsigned c = xb_ld(&bar[XB_XCNT(j)]); sum += c; cnt += (c > 0u) ? 1u : 0u; mine = (j == x) ? c : mine; }
        if (sum == G) break;
        __builtin_amdgcn_s_sleep(1);
        if ((++sp & 255u) == 0u) { if (xb_ld(&bar[XB_TMO])) break; if (sp > XB_SPIN_CAP) { atomicAdd(&bar[XB_TMO], 1u); break; } }
    }
    nloc = mine > 0u ? mine : 1u; nx = cnt > 0u ? cnt : 1u;
}
__device__ __forceinline__ void xcd_barrier(const XcdBarrier& b) {
    asm volatile("s_waitcnt vmcnt(0)" ::: "memory");
    __syncthreads();
    if (threadIdx.x == 0) {
        unsigned* bar = b.bar;
        __builtin_amdgcn_s_waitcnt(0);
        unsigned nloc = b.st[0], nx = b.st[1];
        if (nloc == 0u) { xcd_barrier_complete(bar, b.x, nloc, nx); b.st[0] = nloc; b.st[1] = nx; }
        const unsigned old = xb_add(&bar[XB_XSUB(b.x)], 1u);
        const unsigned gen = old / nloc;
        if (old + 1u == (gen + 1u) * nloc) {
            __builtin_amdgcn_fence(__ATOMIC_RELEASE, "agent");
            asm volatile("s_waitcnt vmcnt(0)" ::: "memory");
            const unsigned og = xb_add(&bar[XB_TOP], 1u);
            const unsigned tg = og / nx;
            if (og + 1u == (tg + 1u) * nx) xb_add(&bar[XB_TOPGEN], 1u);
            else XB_SPIN(xb_ld(&bar[XB_TOPGEN]) == tg, bar);
            __builtin_amdgcn_fence(__ATOMIC_ACQUIRE, "agent");
            xb_add(&bar[XB_XGEN(b.x)], 1u);
            asm volatile("s_waitcnt vmcnt(0)" ::: "memory");
        } else {
            XB_SPIN(xb_ld(&bar[XB_XGEN(b.x)]) == gen, bar);
            __builtin_amdgcn_fence(__ATOMIC_ACQUIRE, "agent");
            asm volatile("s_waitcnt vmcnt(0)" ::: "memory");
        }
    }
    __syncthreads();
}
__global__ void __launch_bounds__(512, 2) mega_fwd(Params Parg) {
    extern __shared__ __attribute__((aligned(16))) unsigned char shm[];
    cg::grid_group grid = cg::this_grid();
    LAS unsigned char* lds = (LAS unsigned char*)shm;
    pg8::StaticOrder S;
    if (threadIdx.x < 4) ((volatile LAS unsigned*)(lds + 147456))[threadIdx.x] = 0u;
    __syncthreads();
    (void)xcd_barrier_post((unsigned*)(kparams()->ws + WS_BAR), (volatile LAS unsigned*)(lds + 147456));
    phase_prologue(kparams(), shm);
    grid.sync();
    phase_norm0_sw(kparams(), shm);
    GSYNC();
#pragma nounroll
    for (int l = 0; l < 2; ++l) {
#pragma nounroll
        for (int sub = 0; sub < 3; ++sub) {
            const int j = l * 3 + sub;
            if (sub != 1) {
                const int s = sub >> 1;
                { KP P = kparams(); const u16* Wl = (const u16*)(P->ws + WS_W) + (size_t)l * W_LAYER;
                  pg8::Gemm g; g.A = (const u16*)(P->ws + WS_U); g.Bt = Wl + (s ? W_GU1 : W_GU0); g.M = NTOK; g.N = 5632; g.K = 1024; EpiGU e; e.hid = (u16*)(P->ws + WS_Z);
                  e.ss = (const float*)(P->ws + WS_SS) + (size_t)j * NTOK; e.sw = (const float*)(P->ws + WS_SW) + (size_t)l * SW_LAYER + (s ? SW_GU1 : SW_GU0);
                  S.init(g.M, g.N, gridDim.x, blockIdx.x); pg8::gemm_phase<EpiGU>(lds, g, S, e); }
                GSYNC();
            } else {
#pragma nounroll
                for (int br = 0; br < 3; ++br) {
                    { KP P = kparams(); const u16* Wl = (const u16*)(P->ws + WS_W) + (size_t)l * W_LAYER;
                      pg8::Gemm g; g.A = (const u16*)(P->ws + WS_U); g.Bt = Wl + (br == 0 ? W_INA : (br == 1 ? W_INB : W_INC)); g.M = NTOK; g.N = br == 0 ? 1536 : 2048; g.K = 1024;
                      EpiBf16 e; e.O = (u16*)(P->ws + WS_P); e.ldc = g.N;
                      e.ss = (const float*)(P->ws + WS_SS) + (size_t)j * NTOK; e.sw = (const float*)(P->ws + WS_SW) + (size_t)l * SW_LAYER + (br == 0 ? SW_INA : (br == 1 ? SW_INB : SW_INC));
                      S.init(g.M, g.N, gridDim.x, blockIdx.x); pg8::gemm_phase<EpiBf16>(lds, g, S, e); }
                    GSYNC();
                    if (br == 0) {
                        phase_attn_prep(kparams(), l, shm); GSYNC();
                        phase_attn(kparams(), l, shm); GSYNC();
                    } else if (br == 1) {
                        phase_lora_prep(kparams(), l); GSYNC();
                        { KP P = kparams(); const u16* Wl = (const u16*)(P->ws + WS_W) + (size_t)l * W_LAYER;
                          pg8::Gemm g; g.A = (const u16*)(P->ws + WS_O); g.Bt = Wl + W_LORA; g.M = NTOK; g.N = 1536; g.K = 384;
                          EpiBf16 e; e.O = (u16*)(P->ws + WS_LO); e.ldc = 1536; e.ss = nullptr; e.sw = nullptr;
                          S.init(g.M, g.N, gridDim.x, blockIdx.x); pg8::gemm_phase<EpiBf16>(lds, g, S, e); }
                        GSYNC();
                        phase_rwkv(kparams(), l, shm); GSYNC();
                    } else {
                        phase_hgrn(kparams(), l, shm); GSYNC();
                        phase_hgrn_post(kparams(), l); GSYNC();
                    }
                    { KP P = kparams(); const u16* Wl = (const u16*)(P->ws + WS_W) + (size_t)l * W_LAYER;
                      pg8::Gemm g; g.A = (const u16*)(P->ws + WS_O); g.Bt = Wl + (br == 0 ? W_OA : (br == 1 ? W_OB : W_OC)); g.M = NTOK; g.N = 1024; g.K = 512;
                      EpiBf16 e; e.O = (u16*)(P->ws + WS_P); e.ldc = 1024; e.ss = nullptr; e.sw = nullptr;
                      S.init(g.M, g.N, gridDim.x, blockIdx.x); pg8::gemm_phase<EpiBf16>(lds, g, S, e); }
                    GSYNC();
                    { KP P = kparams(); const u16* Wl = (const u16*)(P->ws + WS_W) + (size_t)l * W_LAYER;
                      pg8::Gemm g; g.A = (const u16*)(P->ws + WS_U); g.Bt = Wl + W_G + (size_t)br * 1024 * 1024; g.M = NTOK; g.N = 1024; g.K = 1024;
                      EpiGate e; e.Z = (u16*)(P->ws + WS_Z); e.Y = (const u16*)(P->ws + WS_P); e.first = (br == 0);
                      e.ss = (const float*)(P->ws + WS_SS) + (size_t)j * NTOK; e.sw = (const float*)(P->ws + WS_SW) + (size_t)l * SW_LAYER + SW_G + (size_t)br * 1024;
                      S.init(g.M, g.N, gridDim.x, blockIdx.x); pg8::gemm_phase<EpiGate>(lds, g, S, e); }
                    GSYNC();
                }
            }
            { KP P = kparams(); const u16* Wl = (const u16*)(P->ws + WS_W) + (size_t)l * W_LAYER;
              const float* modall = (const float*)(P->ws + WS_MOD);
              const float* modl = modall + (size_t)l * 32 * 9216;
              const bool ffn = (sub != 1); const int jn = j + 1, ln = jn / 3, subn = jn % 3; const bool has_next = jn < 6;
              pg8::Gemm g; g.M = NTOK; g.N = 1024; g.A = (const u16*)(P->ws + WS_Z); g.Bt = Wl + (ffn ? ((sub >> 1) ? W_D1 : W_D0) : W_OUT); g.K = ffn ? DFF : 1024;
              const float* hin_ = (j == 0) ? P->in[0] : (const float*)P->out;
              const float* mv_ = modl + (ffn ? (3 * sub + 2) : 5) * 1024;
              u16* hb_ = (u16*)(P->ws + WS_U);
              float* ssn_ = (float*)(P->ws + WS_SS) + (size_t)(has_next ? jn : 0) * NTOK;
              const float* nwn_ = P->in[5] + (size_t)(has_next ? (ln * 3 + subn) : 0) * 1024;
              const float* scn_ = modall + (size_t)(has_next ? ln : 0) * 32 * 9216 + (3 * (has_next ? subn : 0) + 1) * 1024;
              const EpiRes e = {hin_, P->out, mv_, ffn ? 1 : 0, hb_, ssn_, nwn_, scn_, has_next ? 1 : 0};
              S.init(g.M, g.N, gridDim.x, blockIdx.x); pg8::gemm_phase<EpiRes>(lds, g, S, e); }
            if (j < 5) GSYNC();
        }
    }
}

extern "C" void kernel_launch(void* const* d_in, const int* in_sizes, int n_in, void* d_out, int out_size, void* d_ws, size_t ws_size, hipStream_t stream) {
    static int grid_blocks = 0;
    if (!grid_blocks) {
        int dev = 0, cus = 0, per_cu = 0;
        hipGetDevice(&dev);
        hipDeviceGetAttribute(&cus, hipDeviceAttributeMultiprocessorCount, dev);
        hipFuncSetAttribute((const void*)mega_fwd, hipFuncAttributeMaxDynamicSharedMemorySize, LDS_BYTES);
        hipOccupancyMaxActiveBlocksPerMultiprocessor(&per_cu, (const void*)mega_fwd, 512, LDS_BYTES);
        if (per_cu < 1) per_cu = 1;
        grid_blocks = cus * per_cu;
        if (n_in != 30 || ws_size < 899 * MiB) fprintf(stderr, "kernel_launch: unexpected n_in %d or ws_size %zu (< %zu)\n", n_in, ws_size, (size_t)(899 * MiB));
    }
    Params p{};
    for (int i = 0; i < 30; ++i) p.in[i] = (const float*)d_in[i];
    p.out = (float*)d_out; p.ws = (unsigned char*)d_ws;
    hipMemsetAsync((unsigned char*)d_ws + WS_BAR, 0, XCD_BAR_WORDS * 4, stream);
    void* args[] = {&p};
    hipError_t e = hipLaunchCooperativeKernel((const void*)mega_fwd, dim3(grid_blocks), dim3(512), args, LDS_BYTES, stream);
    if (e != hipSuccess) fprintf(stderr, "cooperative launch failed: %s (grid %d)\n", hipGetErrorString(e), grid_blocks);
}
```
